# Optimizing an MI355X kernel written in HIP

```python
import math
import jax, jax.numpy as jnp
from jax import lax
import numpy as np

D_MODEL = 1024
BATCH = 2
SEQ = 8192
DEPTH = 1

N_Q_HEADS = 8
N_KV_HEADS = 2
HEAD_DIM = 64
ATTN_WIDTH = N_Q_HEADS * HEAD_DIM
KV_WIDTH = N_KV_HEADS * HEAD_DIM
WINDOW = 128
BLOCK = 128
POOL_WINDOWS = (2, 4, 8, 16)
N_POOL_GROUPS = len(POOL_WINDOWS)
POOL_GROUP_WIDTH = 128
POOL_WIDTH = N_POOL_GROUPS * POOL_GROUP_WIDTH
N_BRANCHES = 2
IN_WIDTH = ATTN_WIDTH + 2 * KV_WIDTH + POOL_WIDTH + N_BRANCHES * D_MODEL
N_EXPERTS = 32
TOP_K = 4
D_EXPERT = D_MODEL
SWIGLU_LIMIT = 7.0
SWIGLU_ALPHA = 1.702
MOE_BLOCK = 128
LN_EPS = 1e-5
DEEPNORM_ALPHA = (2.0 * DEPTH) ** 0.25
DEEPNORM_BETA = (8.0 * DEPTH) ** -0.25

kernel_name = 'hybrid_swa_pool_moe_deepnorm_encoder'


def layer_norm(x, g, b):
    xf = x.astype(jnp.float32)
    mean = jnp.mean(xf, axis=-1, keepdims=True)
    var = jnp.mean(jnp.square(xf - mean), axis=-1, keepdims=True)
    y = (xf - mean) * lax.rsqrt(var + LN_EPS)
    return y.astype(x.dtype) * g + b


def alibi_slopes(n_heads):
    return np.asarray([2.0 ** (-8.0 * (h + 1) / n_heads) for h in range(n_heads)], dtype=np.float32)


def windowed_attention(q, k, v, sinks):
    B, S = q.shape[0], q.shape[1]
    nb = S // BLOCK
    G = N_Q_HEADS // N_KV_HEADS
    qb = q.reshape(B, nb, BLOCK, N_KV_HEADS, G, HEAD_DIM)
    pad = ((0, 0), (BLOCK, BLOCK), (0, 0), (0, 0))
    kp = jnp.pad(k, pad).reshape(B, nb + 2, BLOCK, N_KV_HEADS, HEAD_DIM)
    vp = jnp.pad(v, pad).reshape(B, nb + 2, BLOCK, N_KV_HEADS, HEAD_DIM)
    kw = jnp.concatenate([kp[:, :-2], kp[:, 1:-1], kp[:, 2:]], axis=2)
    vw = jnp.concatenate([vp[:, :-2], vp[:, 1:-1], vp[:, 2:]], axis=2)
    scores = jnp.einsum('bnqhgd,bnkhd->bnhgqk', qb, kw).astype(jnp.float32)
    scores = scores * (1.0 / math.sqrt(HEAD_DIM))
    rel = np.arange(3 * BLOCK)[None, :] - BLOCK - np.arange(BLOCK)[:, None]
    key_abs = np.arange(nb)[:, None] * BLOCK - BLOCK + np.arange(3 * BLOCK)[None, :]
    valid = (np.abs(rel) <= WINDOW)[None, :, :] & ((key_abs >= 0) & (key_abs < S))[:, None, :]
    slopes = jnp.asarray(alibi_slopes(N_Q_HEADS)).reshape(N_KV_HEADS, G)
    bias = -slopes[:, :, None, None] * jnp.asarray(np.abs(rel), jnp.float32)[None, None]
    scores = jnp.where(jnp.asarray(valid)[None, :, None, None], scores + bias[None, None], -jnp.inf)
    sink = sinks.astype(jnp.float32).reshape(N_KV_HEADS, G)[None, None, :, :, None, None]
    m = jnp.maximum(jnp.max(scores, axis=-1, keepdims=True), sink)
    p = jnp.exp(scores - m)
    probs = p / (jnp.sum(p, axis=-1, keepdims=True) + jnp.exp(sink - m))
    out = jnp.einsum('bnhgqk,bnkhd->bnqhgd', probs.astype(v.dtype), vw)
    return out.reshape(B, S, ATTN_WIDTH)


def multiscale_pool(p, w_group, scale):
    B, S = p.shape[0], p.shape[1]
    cs = jnp.concatenate([jnp.zeros((B, 1, POOL_WIDTH), jnp.float32),
                          jnp.cumsum(p.astype(jnp.float32), axis=1)], axis=1)
    t = np.arange(S)
    outs = []
    for g, w in enumerate(POOL_WINDOWS):
        sl = slice(g * POOL_GROUP_WIDTH, (g + 1) * POOL_GROUP_WIDTH)
        lo = np.maximum(t - w // 2, 0)
        hi = np.minimum(t + w // 2 - 1, S - 1)
        cnt = jnp.asarray((hi - lo + 1).astype(np.float32))[None, :, None]
        csg = cs[:, :, sl]
        pooled = (csg[:, hi + 1] - csg[:, lo]) / cnt
        outs.append(pooled.astype(p.dtype) - p[:, :, sl])
    y = jnp.stack(outs, axis=2)
    y = jnp.einsum('bsgc,gcd->bsgd', y, w_group).reshape(B, S, POOL_WIDTH)
    return y * scale


def moe_ffn(x, w_router, b_router, w_mlp1, b_mlp1, w_mlp2, b_mlp2):
    B, S, D = x.shape
    N = B * S
    A = N * TOP_K
    xt = x.reshape(N, D)
    logits = (xt @ w_router + b_router).astype(jnp.float32)
    top_vals, top_idx = lax.top_k(logits, TOP_K)
    gates = jax.nn.softmax(top_vals, axis=-1)
    e_flat = top_idx.reshape(A)
    tok_flat = jnp.repeat(jnp.arange(N, dtype=jnp.int32), TOP_K)
    w_flat = gates.reshape(A)
    order = jnp.argsort(e_flat)
    e_sorted = e_flat[order]
    counts = jnp.bincount(e_flat, length=N_EXPERTS)
    padded = ((counts + MOE_BLOCK - 1) // MOE_BLOCK) * MOE_BLOCK
    start = jnp.cumsum(counts) - counts
    pend = jnp.cumsum(padded)
    pstart = pend - padded
    dest = pstart[e_sorted] + (jnp.arange(A) - start[e_sorted])
    R = A + N_EXPERTS * MOE_BLOCK
    nblk = R // MOE_BLOCK
    row_tok = jnp.zeros((R,), jnp.int32).at[dest].set(tok_flat[order])
    row_w = jnp.zeros((R,), jnp.float32).at[dest].set(w_flat[order])
    blk_expert = jnp.minimum(
        jnp.searchsorted(pend, jnp.arange(nblk) * MOE_BLOCK, side='right'), N_EXPERTS - 1)
    xs = xt[row_tok].reshape(nblk, MOE_BLOCK, D)

    def expert_block(args):
        xb, e = args
        h = xb @ w_mlp1[e] + b_mlp1[e]
        gate = jnp.minimum(h[:, :D_EXPERT], SWIGLU_LIMIT)
        up = jnp.clip(h[:, D_EXPERT:], -SWIGLU_LIMIT, SWIGLU_LIMIT)
        act = (up + 1.0) * gate * jax.nn.sigmoid(SWIGLU_ALPHA * gate)
        return act @ w_mlp2[e] + b_mlp2[e]

    ys = lax.map(expert_block, (xs, blk_expert)).reshape(R, D)
    ys = ys * row_w[:, None].astype(ys.dtype)
    out = jax.ops.segment_sum(ys, row_tok, num_segments=N)
    return out.reshape(B, S, D)


def setup_inputs(seed: int = 0) -> dict:
    key = jax.random.key(seed)
    ks = jax.random.split(key, 20)
    L, D, E, F = DEPTH, D_MODEL, N_EXPERTS, D_EXPERT
    nrm = lambda k, shape: jax.random.normal(k, shape, jnp.float32)
    col_scale = np.ones((IN_WIDTH,), np.float32)
    v0 = ATTN_WIDTH + KV_WIDTH
    col_scale[v0:v0 + KV_WIDTH] = DEEPNORM_BETA
    w_in = nrm(ks[1], (L, D, IN_WIDTH)) * (D ** -0.5) * jnp.asarray(col_scale)
    return {
        'x': nrm(ks[0], (BATCH, SEQ, D)),
        'w_in': w_in,
        'attn_sinks': nrm(ks[2], (L, N_Q_HEADS)),
        'w_attn_branch': nrm(ks[3], (L, ATTN_WIDTH, D)) * (ATTN_WIDTH ** -0.5),
        'w_pool_group': nrm(ks[4], (L, N_POOL_GROUPS, POOL_GROUP_WIDTH, POOL_GROUP_WIDTH)) * (POOL_GROUP_WIDTH ** -0.5),
        'pool_scale': 1.0 + 0.1 * nrm(ks[5], (L, POOL_WIDTH)),
        'w_pool_branch': nrm(ks[6], (L, POOL_WIDTH, D)) * (POOL_WIDTH ** -0.5),
        'w_out': nrm(ks[7], (L, D, D)) * (D ** -0.5) * DEEPNORM_BETA,
        'ln1_g': 1.0 + 0.02 * nrm(ks[8], (L, D)),
        'ln1_b': 0.02 * nrm(ks[9], (L, D)),
        'w_router': nrm(ks[10], (L, D, E)) * (D ** -0.5),
        'b_router': 0.01 * nrm(ks[11], (L, E)),
        'w_mlp1': nrm(ks[12], (L, E, D, 2 * F)) * (D ** -0.5) * DEEPNORM_BETA,
        'b_mlp1': 0.01 * nrm(ks[13], (L, E, 2 * F)),
        'w_mlp2': nrm(ks[14], (L, E, F, D)) * (F ** -0.5) * DEEPNORM_BETA,
        'b_mlp2': 0.01 * nrm(ks[15], (L, E, D)),
        'ln2_g': 1.0 + 0.02 * nrm(ks[16], (L, D)),
        'ln2_b': 0.02 * nrm(ks[17], (L, D)),
    }


def reference(x, w_in, attn_sinks, w_attn_branch, w_pool_group, pool_scale, w_pool_branch,
              w_out, ln1_g, ln1_b, w_router, b_router, w_mlp1, b_mlp1, w_mlp2, b_mlp2,
              ln2_g, ln2_b):
    B, S, D = x.shape
    o_k = ATTN_WIDTH
    o_v = o_k + KV_WIDTH
    o_p = o_v + KV_WIDTH
    o_g = o_p + POOL_WIDTH
    h = x
    for l in range(DEPTH):
        u = h @ w_in[l]
        q = u[..., :o_k].reshape(B, S, N_Q_HEADS, HEAD_DIM)
        k = u[..., o_k:o_v].reshape(B, S, N_KV_HEADS, HEAD_DIM)
        v = u[..., o_v:o_p].reshape(B, S, N_KV_HEADS, HEAD_DIM)
        p_in = u[..., o_p:o_g]
        g_attn = jax.nn.sigmoid(u[..., o_g:o_g + D])
        g_pool = jax.nn.sigmoid(u[..., o_g + D:o_g + 2 * D])
        a_br = windowed_attention(q, k, v, attn_sinks[l]) @ w_attn_branch[l]
        p_br = multiscale_pool(p_in, w_pool_group[l], pool_scale[l]) @ w_pool_branch[l]
        mixed = g_attn * a_br + g_pool * p_br
        h = layer_norm(DEEPNORM_ALPHA * h + mixed @ w_out[l], ln1_g[l], ln1_b[l])
        f = moe_ffn(h, w_router[l], b_router[l], w_mlp1[l], b_mlp1[l], w_mlp2[l], b_mlp2[l])
        h = layer_norm(DEEPNORM_ALPHA * h + f, ln2_g[l], ln2_b[l])
    return h
```

```cpp
#include <hip/hip_runtime.h>
#include <stdint.h>
#include <cstdio>

typedef unsigned short bf16_t;
typedef short bf16x8 __attribute__((ext_vector_type(8)));
typedef float f32x4 __attribute__((ext_vector_type(4)));

constexpr int NTOK = 16384, DM = 1024, SEQ = 8192, INW = 3328;
constexpr int OQ = 0, OKK = 512, OV = 640, OP = 768, OGA = 1280, OGP = 2304;
constexpr int NE = 32, TOPK = 4, DE = 1024;
constexpr int MAXROWS = NTOK * TOPK + NE * 256;
constexpr int MAXTILES = MAXROWS / 256;
constexpr float ALPHA = 1.189207115002721f;
constexpr float LN_EPS = 1e-5f;

constexpr size_t WS_CTL = 0;
constexpr size_t WS_U = 8192;
constexpr size_t SZ_U = (size_t)NTOK * INW * 2;
constexpr size_t SZ_A16 = (size_t)NTOK * DM * 2;
constexpr size_t WS_AY = WS_U + SZ_U;
constexpr size_t WS_MIX = WS_AY + SZ_A16;
constexpr size_t WS_H1B = WS_MIX + SZ_A16;
constexpr size_t WS_XB = WS_H1B + SZ_A16;
constexpr size_t WS_Z = WS_XB + SZ_A16;
constexpr size_t WS_STAT = WS_Z + (size_t)NTOK * DM * 4;
constexpr size_t WS_TE = WS_STAT + (size_t)NTOK * 8;
constexpr size_t WS_TG = WS_TE + (size_t)NTOK * 16;
constexpr size_t WS_TR = WS_TG + (size_t)NTOK * 16;
constexpr size_t WS_TD = WS_TR + (size_t)NTOK * 16;
constexpr size_t WS_XS = WS_TD + (size_t)NTOK * 16;
constexpr size_t SZ_XS = (size_t)MAXROWS * DM * 2;
constexpr size_t WS_ACT = WS_XS + SZ_XS;
constexpr size_t WS_END = WS_ACT + SZ_XS;

__device__ __forceinline__ bf16_t f2bf(float f) { uint32_t u = __float_as_uint(f); u += 0x7fffu + ((u >> 16) & 1u); return (bf16_t)(u >> 16); }
__device__ __forceinline__ float bf2f(bf16_t b) { return __uint_as_float(((uint32_t)b) << 16); }
__device__ __forceinline__ float sigmoidf_(float x) { return 1.0f / (1.0f + __expf(-x)); }

__device__ __forceinline__ float wave_sum(float v) {
#pragma unroll
    for (int o = 1; o < 64; o <<= 1) v += __shfl_xor(v, o);
    return v;
}
__device__ __forceinline__ float wave_max(float v) {
#pragma unroll
    for (int o = 1; o < 64; o <<= 1) v = fmaxf(v, __shfl_xor(v, o));
    return v;
}

__global__ __launch_bounds__(256) void k_xconv(const float* __restrict__ x, bf16_t* __restrict__ xb) {
    size_t i = ((size_t)blockIdx.x * 256 + threadIdx.x) * 8;
    f32x4 a = *(const f32x4*)(x + i), b = *(const f32x4*)(x + i + 4);
    bf16x8 o;
    o[0] = f2bf(a[0]); o[1] = f2bf(a[1]); o[2] = f2bf(a[2]); o[3] = f2bf(a[3]);
    o[4] = f2bf(b[0]); o[5] = f2bf(b[1]); o[6] = f2bf(b[2]); o[7] = f2bf(b[3]);
    *(bf16x8*)(xb + i) = o;
}

struct GemmArgs { const bf16_t* A; const float* B; const int* tile_e; const int* ntiles; size_t bstrideE; int lda, ldb, K, dualoff; };

template <class Epi, bool DUAL>
__global__ __launch_bounds__(256) void gemm_v1(GemmArgs g, Epi epi) {
    const int wave = threadIdx.x >> 6, l = threadIdx.x & 63, fr = l & 15, fq = l >> 4;
    const int m0 = blockIdx.y * 64, n0 = blockIdx.x * 64 + wave * 16;
    const float* B = g.B; int e = 0;
    if (g.tile_e) { if ((m0 >> 8) >= *g.ntiles) return; e = g.tile_e[m0 >> 8]; B += (size_t)e * g.bstrideE; }
    f32x4 acc[4], acc2[4];
#pragma unroll
    for (int i = 0; i < 4; ++i) { acc[i] = (f32x4){0.f, 0.f, 0.f, 0.f}; acc2[i] = (f32x4){0.f, 0.f, 0.f, 0.f}; }
    for (int k0 = 0; k0 < g.K; k0 += 32) {
        bf16x8 b, b2;
#pragma unroll
        for (int j = 0; j < 8; ++j) {
            const float* bp = B + (size_t)(k0 + 8 * fq + j) * g.ldb + n0 + fr;
            b[j] = (short)f2bf(bp[0]);
            if (DUAL) b2[j] = (short)f2bf(bp[g.dualoff]);
        }
#pragma unroll
        for (int i = 0; i < 4; ++i) {
            const bf16x8 a = *(const bf16x8*)(g.A + (size_t)(m0 + 16 * i + fr) * g.lda + k0 + 8 * fq);
            acc[i] = __builtin_amdgcn_mfma_f32_16x16x32_bf16(a, b, acc[i], 0, 0, 0);
            if (DUAL) acc2[i] = __builtin_amdgcn_mfma_f32_16x16x32_bf16(a, b2, acc2[i], 0, 0, 0);
        }
    }
#pragma unroll
    for (int i = 0; i < 4; ++i)
#pragma unroll
        for (int r = 0; r < 4; ++r) epi(m0 + 16 * i + 4 * fq + r, n0 + fr, acc[i][r], acc2[i][r], e);
}

struct EpiInproj { bf16_t* U;
    __device__ void operator()(int row, int col, float v, float, int) const {
        float o = v;
        if (col < OKK) o = v * 0.125f; else if (col >= OGA) o = sigmoidf_(v);
        U[(size_t)row * INW + col] = f2bf(o); } };
struct EpiBrA { const bf16_t* U; float* T;
    __device__ void operator()(int row, int col, float v, float, int) const { T[(size_t)row * DM + col] = bf2f(U[(size_t)row * INW + OGA + col]) * v; } };
struct EpiBrP { const bf16_t* U; const float* T; bf16_t* MIX;
    __device__ void operator()(int row, int col, float v, float, int) const { MIX[(size_t)row * DM + col] = f2bf(T[(size_t)row * DM + col] + bf2f(U[(size_t)row * INW + OGP + col]) * v); } };
struct EpiOut { const float* x; float* Z;
    __device__ void operator()(int row, int col, float v, float, int) const { Z[(size_t)row * DM + col] = ALPHA * x[(size_t)row * DM + col] + v; } };
struct EpiMlp1 { const float* b1; bf16_t* ACT;
    __device__ void operator()(int row, int col, float vg, float vu, int e) const {
        vg += b1[(size_t)e * 2 * DE + col]; vu += b1[(size_t)e * 2 * DE + DE + col];
        const float gate = fminf(vg, 7.0f), up = fminf(fmaxf(vu, -7.0f), 7.0f);
        ACT[(size_t)row * DE + col] = f2bf((up + 1.0f) * gate * sigmoidf_(1.702f * gate)); } };
struct EpiMlp2 { const float* b2; bf16_t* YB;
    __device__ void operator()(int row, int col, float v, float, int e) const { YB[(size_t)row * DM + col] = f2bf(v + b2[(size_t)e * DM + col]); } };

__global__ __launch_bounds__(64) void k_attn_v1(const bf16_t* __restrict__ U, const float* __restrict__ sinks, bf16_t* __restrict__ AY) {
    const int tok = blockIdx.x >> 3, h = blockIdx.x & 7, b = tok / SEQ, t = tok % SEQ, kvh = h >> 2, lane = threadIdx.x;
    __shared__ float pbuf[320]; __shared__ float qs[64];
    qs[lane] = bf2f(U[(size_t)tok * INW + OQ + h * 64 + lane]);
    __syncthreads();
    const int lo = max(t - 128, 0), hi = min(t + 128, SEQ - 1), nk = hi - lo + 1;
    const float slope = exp2f(-(float)(h + 1)), sink = sinks[h];
    float sc[5]; float mx = -INFINITY;
#pragma unroll
    for (int i = 0; i < 5; ++i) {
        const int idx = lane + 64 * i; sc[i] = -INFINITY;
        if (idx < nk) {
            const int s = lo + idx; const bf16_t* kr = U + (size_t)(b * SEQ + s) * INW + OKK + kvh * 64; float d = 0.f;
            for (int c = 0; c < 64; ++c) d += qs[c] * bf2f(kr[c]);
            sc[i] = d - slope * fabsf((float)(s - t)); mx = fmaxf(mx, sc[i]);
        }
    }
    const float m = fmaxf(wave_max(mx), sink);
    float ps = 0.f;
#pragma unroll
    for (int i = 0; i < 5; ++i) { sc[i] = __expf(sc[i] - m); ps += sc[i]; }
    const float inv = 1.0f / (wave_sum(ps) + __expf(sink - m));
#pragma unroll
    for (int i = 0; i < 5; ++i) { const int idx = lane + 64 * i; if (idx < 320) pbuf[idx] = sc[i] * inv; }
    __syncthreads();
    float o = 0.f;
    for (int idx = 0; idx < nk; ++idx) o += pbuf[idx] * bf2f(U[(size_t)(b * SEQ + lo + idx) * INW + OV + kvh * 64 + lane]);
    AY[(size_t)tok * DM + h * 64 + lane] = f2bf(o);
}

__global__ __launch_bounds__(256) void k_pool_v1(const bf16_t* __restrict__ U, const float* __restrict__ wg, const float* __restrict__ scale, bf16_t* __restrict__ AY) {
    const int tok = blockIdx.x, b = tok / SEQ, t = tok % SEQ;
    __shared__ float y[512];
    for (int c = threadIdx.x; c < 512; c += 256) {
        const int g = c >> 7, w = 2 << g, lo = max(t - w / 2, 0), hi = min(t + w / 2 - 1, SEQ - 1);
        float s = 0.f;
        for (int q = lo; q <= hi; ++q) s += bf2f(U[(size_t)(b * SEQ + q) * INW + OP + c]);
        y[c] = s / (float)(hi - lo + 1) - bf2f(U[(size_t)tok * INW + OP + c]);
    }
    __syncthreads();
    for (int o = threadIdx.x; o < 512; o += 256) {
        const int g = o >> 7, d = o & 127; float a = 0.f;
        for (int c = 0; c < 128; ++c) a += y[g * 128 + c] * wg[(size_t)(g * 128 + c) * 128 + d];
        AY[(size_t)tok * DM + 512 + o] = f2bf(a * scale[o]);
    }
}

__global__ __launch_bounds__(256) void k_ln_router_v1(const float* __restrict__ Z, const float* __restrict__ g1, const float* __restrict__ b1, const float* __restrict__ wr, const float* __restrict__ br,
                                                      bf16_t* __restrict__ H1B, float* __restrict__ STAT, int* cnt, int* te, float* tg, int* tr) {
    const int tok = blockIdx.x, tid = threadIdx.x, wave = tid >> 6, lane = tid & 63;
    __shared__ float hs[1024]; __shared__ float red[8]; __shared__ float lg[32];
    const f32x4 v = *(const f32x4*)(Z + (size_t)tok * DM + 4 * tid);
    float s = wave_sum((v[0] + v[1]) + (v[2] + v[3]));
    if (lane == 0) red[wave] = s;
    __syncthreads();
    const float mean = (red[0] + red[1] + red[2] + red[3]) * (1.0f / DM);
    const f32x4 d = v - mean;
    float q = wave_sum((d[0] * d[0] + d[1] * d[1]) + (d[2] * d[2] + d[3] * d[3]));
    if (lane == 0) red[4 + wave] = q;
    __syncthreads();
    const float rstd = rsqrtf((red[4] + red[5] + red[6] + red[7]) * (1.0f / DM) + LN_EPS);
    const f32x4 gg = *(const f32x4*)(g1 + 4 * tid), bb = *(const f32x4*)(b1 + 4 * tid);
    const f32x4 hv = d * rstd * gg + bb;
    *(f32x4*)(hs + 4 * tid) = hv;
    bf16_t* hb = H1B + (size_t)tok * DM + 4 * tid;
    hb[0] = f2bf(hv[0]); hb[1] = f2bf(hv[1]); hb[2] = f2bf(hv[2]); hb[3] = f2bf(hv[3]);
    if (tid == 0) { STAT[2 * tok] = mean; STAT[2 * tok + 1] = rstd; }
    __syncthreads();
    for (int e = 8 * wave; e < 8 * wave + 8; ++e) {
        float p = 0.f;
        for (int i = 0; i < 16; ++i) { const int c = lane + 64 * i; p += hs[c] * wr[(size_t)c * NE + e]; }
        p = wave_sum(p);
        if (lane == 0) lg[e] = p + br[e];
    }
    __syncthreads();
    if (tid == 0) {
        float sv[4]; int se[4];
#pragma unroll
        for (int k = 0; k < 4; ++k) {
            float best = -INFINITY; int bi = 0;
            for (int e = 0; e < NE; ++e) { const float x = lg[e]; if (x > best) { best = x; bi = e; } }
            sv[k] = best; se[k] = bi; lg[bi] = -INFINITY;
        }
        float ex[4], sum = 0.f;
#pragma unroll
        for (int k = 0; k < 4; ++k) { ex[k] = __expf(sv[k] - sv[0]); sum += ex[k]; }
#pragma unroll
        for (int k = 0; k < 4; ++k) {
            te[tok * 4 + k] = se[k]; tg[tok * 4 + k] = ex[k] / sum; tr[tok * 4 + k] = atomicAdd(&cnt[se[k]], 1);
        }
    }
}

__global__ void k_book(int* ctl) {
    if (threadIdx.x == 0) {
        int ps = 0;
        for (int e = 0; e < NE; ++e) { ctl[64 + e] = ps; const int nt = (ctl[e] + 255) >> 8; for (int i = 0; i < nt; ++i) ctl[256 + (ps >> 8) + i] = e; ps += nt << 8; }
        ctl[64 + NE] = ps; ctl[128] = ps >> 8;
    }
}

__global__ __launch_bounds__(128) void k_gather_v1(const bf16_t* __restrict__ H1B, const int* __restrict__ ctl, const int* __restrict__ te, const int* __restrict__ tr, int* __restrict__ td, bf16_t* __restrict__ XS) {
    const int a = blockIdx.x, tok = a >> 2;
    const int dest = ctl[64 + te[a]] + tr[a];
    if (threadIdx.x == 0) td[a] = dest;
    *(bf16x8*)(XS + (size_t)dest * DM + 8 * threadIdx.x) = *(const bf16x8*)(H1B + (size_t)tok * DM + 8 * threadIdx.x);
}

__global__ __launch_bounds__(256) void k_final_v1(const float* __restrict__ Z, const float* __restrict__ STAT, const float* __restrict__ g1, const float* __restrict__ b1, const bf16_t* __restrict__ YB,
                                                  const int* __restrict__ td, const float* __restrict__ tg, const float* __restrict__ g2, const float* __restrict__ b2, float* __restrict__ out) {
    const int tok = blockIdx.x, tid = threadIdx.x, wave = tid >> 6, lane = tid & 63;
    __shared__ float red[8];
    const f32x4 z = *(const f32x4*)(Z + (size_t)tok * DM + 4 * tid);
    const float mean1 = STAT[2 * tok], rstd1 = STAT[2 * tok + 1];
    const f32x4 h1 = (z - mean1) * rstd1 * *(const f32x4*)(g1 + 4 * tid) + *(const f32x4*)(b1 + 4 * tid);
    f32x4 f = (f32x4){0.f, 0.f, 0.f, 0.f};
#pragma unroll
    for (int k = 0; k < 4; ++k) {
        const bf16_t* yr = YB + (size_t)td[tok * 4 + k] * DM + 4 * tid; const float w = tg[tok * 4 + k];
        f[0] += w * bf2f(yr[0]); f[1] += w * bf2f(yr[1]); f[2] += w * bf2f(yr[2]); f[3] += w * bf2f(yr[3]);
    }
    const f32x4 v = ALPHA * h1 + f;
    float s = wave_sum((v[0] + v[1]) + (v[2] + v[3]));
    if (lane == 0) red[wave] = s;
    __syncthreads();
    const float mean = (red[0] + red[1] + red[2] + red[3]) * (1.0f / DM);
    const f32x4 d = v - mean;
    float q = wave_sum((d[0] * d[0] + d[1] * d[1]) + (d[2] * d[2] + d[3] * d[3]));
    if (lane == 0) red[4 + wave] = q;
    __syncthreads();
    const float rstd = rsqrtf((red[4] + red[5] + red[6] + red[7]) * (1.0f / DM) + LN_EPS);
    *(f32x4*)(out + (size_t)tok * DM + 4 * tid) = d * rstd * *(const f32x4*)(g2 + 4 * tid) + *(const f32x4*)(b2 + 4 * tid);
}

extern "C" void kernel_launch(void* const* d_in, const int* in_sizes, int n_in, void* d_out, int out_size, void* d_ws, size_t ws_size, hipStream_t stream) {
    if (n_in != 18 || ws_size < WS_END) { fprintf(stderr, "kernel_launch: unexpected n_in %d / ws_size %zu (need %zu)\n", n_in, ws_size, (size_t)WS_END); return; }
    const float* x = (const float*)d_in[0]; const float* w_in = (const float*)d_in[1]; const float* sinks = (const float*)d_in[2];
    const float* w_ab = (const float*)d_in[3]; const float* w_pg = (const float*)d_in[4]; const float* pscale = (const float*)d_in[5];
    const float* w_pb = (const float*)d_in[6]; const float* w_out = (const float*)d_in[7]; const float* ln1g = (const float*)d_in[8];
    const float* ln1b = (const float*)d_in[9]; const float* w_r = (const float*)d_in[10]; const float* b_r = (const float*)d_in[11];
    const float* w1 = (const float*)d_in[12]; const float* b1 = (const float*)d_in[13]; const float* w2 = (const float*)d_in[14];
    const float* b2 = (const float*)d_in[15]; const float* ln2g = (const float*)d_in[16]; const float* ln2b = (const float*)d_in[17];
    char* ws = (char*)d_ws; float* out = (float*)d_out;
    int* ctl = (int*)(ws + WS_CTL); bf16_t* U = (bf16_t*)(ws + WS_U); bf16_t* AY = (bf16_t*)(ws + WS_AY); bf16_t* MIX = (bf16_t*)(ws + WS_MIX);
    bf16_t* H1B = (bf16_t*)(ws + WS_H1B); bf16_t* XB = (bf16_t*)(ws + WS_XB); float* Z = (float*)(ws + WS_Z); float* STAT = (float*)(ws + WS_STAT);
    int* te = (int*)(ws + WS_TE); float* tg = (float*)(ws + WS_TG); int* tr = (int*)(ws + WS_TR); int* td = (int*)(ws + WS_TD);
    bf16_t* XS = (bf16_t*)(ws + WS_XS); bf16_t* ACT = (bf16_t*)(ws + WS_ACT); float* T = (float*)(ws + WS_ACT); bf16_t* YB = XS;

    hipMemsetAsync(ctl, 0, 8192, stream);
    k_xconv<<<NTOK * DM / 8 / 256, 256, 0, stream>>>(x, XB);
    { GemmArgs g{XB, w_in, nullptr, nullptr, 0, DM, INW, DM, 0}; gemm_v1<EpiInproj, false><<<dim3(INW / 64, NTOK / 64), 256, 0, stream>>>(g, EpiInproj{U}); }
    k_attn_v1<<<NTOK * 8, 64, 0, stream>>>(U, sinks, AY);
    k_pool_v1<<<NTOK, 256, 0, stream>>>(U, w_pg, pscale, AY);
    { GemmArgs g{AY, w_ab, nullptr, nullptr, 0, DM, DM, 512, 0}; gemm_v1<EpiBrA, false><<<dim3(DM / 64, NTOK / 64), 256, 0, stream>>>(g, EpiBrA{U, T}); }
    { GemmArgs g{AY + 512, w_pb, nullptr, nullptr, 0, DM, DM, 512, 0}; gemm_v1<EpiBrP, false><<<dim3(DM / 64, NTOK / 64), 256, 0, stream>>>(g, EpiBrP{U, T, MIX}); }
    { GemmArgs g{MIX, w_out, nullptr, nullptr, 0, DM, DM, DM, 0}; gemm_v1<EpiOut, false><<<dim3(DM / 64, NTOK / 64), 256, 0, stream>>>(g, EpiOut{x, Z}); }
    k_ln_router_v1<<<NTOK, 256, 0, stream>>>(Z, ln1g, ln1b, w_r, b_r, H1B, STAT, ctl, te, tg, tr);
    k_book<<<1, 64, 0, stream>>>(ctl);
    k_gather_v1<<<NTOK * 4, 128, 0, stream>>>(H1B, ctl, te, tr, td, XS);
    { GemmArgs g{XS, w1, ctl + 256, ctl + 128, (size_t)DM * 2 * DE, DM, 2 * DE, DM, DE}; gemm_v1<EpiMlp1, true><<<dim3(DE / 64, MAXROWS / 64), 256, 0, stream>>>(g, EpiMlp1{b1, ACT}); }
    { GemmArgs g{ACT, w2, ctl + 256, ctl + 128, (size_t)DE * DM, DE, DM, DE, 0}; gemm_v1<EpiMlp2, false><<<dim3(DM / 64, MAXROWS / 64), 256, 0, stream>>>(g, EpiMlp2{b2, YB}); }
    k_final_v1<<<NTOK, 256, 0, stream>>>(Z, STAT, ln1g, ln1b, YB, td, tg, ln2g, ln2b, out);
}
```

```cpp
#include <hip/hip_runtime.h>
#include <stdint.h>
#include <cstdio>

typedef unsigned short bf16_t;
typedef short bf16x8 __attribute__((ext_vector_type(8)));
typedef float f32x4 __attribute__((ext_vector_type(4)));

constexpr int NTOK = 16384, DM = 1024, SEQ = 8192, INW = 3328;
constexpr int OQ = 0, OKK = 512, OV = 640, OP = 768, OGA = 1280, OGP = 2304;
constexpr int NE = 32, TOPK = 4, DE = 1024;
constexpr int MAXROWS = NTOK * TOPK + NE * 256;
constexpr int MAXTILES = MAXROWS / 256;
constexpr float ALPHA = 1.189207115002721f;
constexpr float LN_EPS = 1e-5f;

constexpr size_t WS_CTL = 0, CTL_BYTES = 262144;
constexpr size_t WS_U = CTL_BYTES;
constexpr size_t SZ_U = (size_t)NTOK * INW * 2;
constexpr size_t SZ_A16 = (size_t)NTOK * DM * 2;
constexpr size_t WS_AY = WS_U + SZ_U;
constexpr size_t WS_MIX = WS_AY + SZ_A16;
constexpr size_t WS_H1B = WS_MIX + SZ_A16;
constexpr size_t WS_XB = WS_H1B + SZ_A16;
constexpr size_t WS_Z = WS_XB + SZ_A16;
constexpr size_t WS_STAT = WS_Z + (size_t)NTOK * DM * 4;
constexpr size_t WS_TE = WS_STAT + (size_t)NTOK * 8;
constexpr size_t WS_TG = WS_TE + (size_t)NTOK * 16;
constexpr size_t WS_TR = WS_TG + (size_t)NTOK * 16;
constexpr size_t WS_TD = WS_TR + (size_t)NTOK * 16;
constexpr size_t WS_XS = WS_TD + (size_t)NTOK * 16;
constexpr size_t SZ_XS = (size_t)MAXROWS * DM * 2;
constexpr size_t WS_ACT = WS_XS + SZ_XS;
constexpr size_t WS_WIN = WS_ACT + SZ_XS;
constexpr size_t WS_WAB = WS_WIN + (size_t)INW * DM * 2;
constexpr size_t WS_WO = WS_WAB + (size_t)DM * DM * 2;
constexpr size_t WS_WG = WS_WO + (size_t)DM * DM * 2;
constexpr size_t WS_W1 = WS_WG + (size_t)4 * 128 * 128 * 2;
constexpr size_t WS_W2 = WS_W1 + (size_t)NE * 2 * DE * DM * 2;
constexpr size_t WS_WR = WS_W2 + (size_t)NE * DE * DM * 2;
constexpr size_t WS_END = WS_WR + (size_t)NE * DM * 4 + 256;
constexpr int CW_BAR = 4096;

__device__ __forceinline__ bf16_t f2bf(float f) { uint32_t u = __float_as_uint(f); u += 0x7fffu + ((u >> 16) & 1u); return (bf16_t)(u >> 16); }
__device__ __forceinline__ float bf2f(bf16_t b) { return __uint_as_float(((uint32_t)b) << 16); }
__device__ __forceinline__ float sigmoidf_(float x) { return 1.0f / (1.0f + __expf(-x)); }

__device__ __forceinline__ float wave_sum(float v) {
#pragma unroll
    for (int o = 1; o < 64; o <<= 1) v += __shfl_xor(v, o);
    return v;
}
__device__ __forceinline__ float wave_max(float v) {
#pragma unroll
    for (int o = 1; o < 64; o <<= 1) v = fmaxf(v, __shfl_xor(v, o));
    return v;
}

__global__ __launch_bounds__(256) void k_xconv(const float* __restrict__ x, bf16_t* __restrict__ xb) {
    size_t i = ((size_t)blockIdx.x * 256 + threadIdx.x) * 8;
    f32x4 a = *(const f32x4*)(x + i), b = *(const f32x4*)(x + i + 4);
    bf16x8 o;
    o[0] = f2bf(a[0]); o[1] = f2bf(a[1]); o[2] = f2bf(a[2]); o[3] = f2bf(a[3]);
    o[4] = f2bf(b[0]); o[5] = f2bf(b[1]); o[6] = f2bf(b[2]); o[7] = f2bf(b[3]);
    *(bf16x8*)(xb + i) = o;
}

struct GemmArgs { const bf16_t* A; const float* B; const int* tile_e; const int* ntiles; size_t bstrideE; int lda, ldb, K, dualoff; };

template <class Epi, bool DUAL>
__global__ __launch_bounds__(256) void gemm_v1(GemmArgs g, Epi epi) {
    const int wave = threadIdx.x >> 6, l = threadIdx.x & 63, fr = l & 15, fq = l >> 4;
    const int m0 = blockIdx.y * 64, n0 = blockIdx.x * 64 + wave * 16;
    const float* B = g.B; int e = 0;
    if (g.tile_e) { if ((m0 >> 8) >= *g.ntiles) return; e = g.tile_e[m0 >> 8]; B += (size_t)e * g.bstrideE; }
    f32x4 acc[4], acc2[4];
#pragma unroll
    for (int i = 0; i < 4; ++i) { acc[i] = (f32x4){0.f, 0.f, 0.f, 0.f}; acc2[i] = (f32x4){0.f, 0.f, 0.f, 0.f}; }
    for (int k0 = 0; k0 < g.K; k0 += 32) {
        bf16x8 b, b2;
#pragma unroll
        for (int j = 0; j < 8; ++j) {
            const float* bp = B + (size_t)(k0 + 8 * fq + j) * g.ldb + n0 + fr;
            b[j] = (short)f2bf(bp[0]);
            if (DUAL) b2[j] = (short)f2bf(bp[g.dualoff]);
        }
#pragma unroll
        for (int i = 0; i < 4; ++i) {
            const bf16x8 a = *(const bf16x8*)(g.A + (size_t)(m0 + 16 * i + fr) * g.lda + k0 + 8 * fq);
            acc[i] = __builtin_amdgcn_mfma_f32_16x16x32_bf16(a, b, acc[i], 0, 0, 0);
            if (DUAL) acc2[i] = __builtin_amdgcn_mfma_f32_16x16x32_bf16(a, b2, acc2[i], 0, 0, 0);
        }
    }
#pragma unroll
    for (int i = 0; i < 4; ++i)
#pragma unroll
        for (int r = 0; r < 4; ++r) epi(m0 + 16 * i + 4 * fq + r, n0 + fr, acc[i][r], acc2[i][r], e);
}

struct EpiInproj { bf16_t* U;
    __device__ void operator()(int row, int col, float v, float, int) const {
        float o = v;
        if (col < OKK) o = v * 0.125f; else if (col >= OGA) o = sigmoidf_(v);
        U[(size_t)row * INW + col] = f2bf(o); } };
struct EpiBrA { const bf16_t* U; float* T;
    __device__ void operator()(int row, int col, float v, float, int) const { T[(size_t)row * DM + col] = bf2f(U[(size_t)row * INW + OGA + col]) * v; } };
struct EpiBrP { const bf16_t* U; const float* T; bf16_t* MIX;
    __device__ void operator()(int row, int col, float v, float, int) const { MIX[(size_t)row * DM + col] = f2bf(T[(size_t)row * DM + col] + bf2f(U[(size_t)row * INW + OGP + col]) * v); } };
struct EpiOut { const float* x; float* Z;
    __device__ void operator()(int row, int col, float v, float, int) const { Z[(size_t)row * DM + col] = ALPHA * x[(size_t)row * DM + col] + v; } };
struct EpiMlp1 { const float* b1; bf16_t* ACT;
    __device__ void operator()(int row, int col, float vg, float vu, int e) const {
        vg += b1[(size_t)e * 2 * DE + col]; vu += b1[(size_t)e * 2 * DE + DE + col];
        const float gate = fminf(vg, 7.0f), up = fminf(fmaxf(vu, -7.0f), 7.0f);
        ACT[(size_t)row * DE + col] = f2bf((up + 1.0f) * gate * sigmoidf_(1.702f * gate)); } };
struct EpiMlp2 { const float* b2; bf16_t* YB;
    __device__ void operator()(int row, int col, float v, float, int e) const { YB[(size_t)row * DM + col] = f2bf(v + b2[(size_t)e * DM + col]); } };

__global__ __launch_bounds__(64) void k_attn_v1(const bf16_t* __restrict__ U, const float* __restrict__ sinks, bf16_t* __restrict__ AY) {
    const int tok = blockIdx.x >> 3, h = blockIdx.x & 7, b = tok / SEQ, t = tok % SEQ, kvh = h >> 2, lane = threadIdx.x;
    __shared__ float pbuf[320]; __shared__ float qs[64];
    qs[lane] = bf2f(U[(size_t)tok * INW + OQ + h * 64 + lane]);
    __syncthreads();
    const int lo = max(t - 128, 0), hi = min(t + 128, SEQ - 1), nk = hi - lo + 1;
    const float slope = exp2f(-(float)(h + 1)), sink = sinks[h];
    float sc[5]; float mx = -INFINITY;
#pragma unroll
    for (int i = 0; i < 5; ++i) {
        const int idx = lane + 64 * i; sc[i] = -INFINITY;
        if (idx < nk) {
            const int s = lo + idx; const bf16_t* kr = U + (size_t)(b * SEQ + s) * INW + OKK + kvh * 64; float d = 0.f;
            for (int c = 0; c < 64; ++c) d += qs[c] * bf2f(kr[c]);
            sc[i] = d - slope * fabsf((float)(s - t)); mx = fmaxf(mx, sc[i]);
        }
    }
    const float m = fmaxf(wave_max(mx), sink);
    float ps = 0.f;
#pragma unroll
    for (int i = 0; i < 5; ++i) { sc[i] = __expf(sc[i] - m); ps += sc[i]; }
    const float inv = 1.0f / (wave_sum(ps) + __expf(sink - m));
#pragma unroll
    for (int i = 0; i < 5; ++i) { const int idx = lane + 64 * i; if (idx < 320) pbuf[idx] = sc[i] * inv; }
    __syncthreads();
    float o = 0.f;
    for (int idx = 0; idx < nk; ++idx) o += pbuf[idx] * bf2f(U[(size_t)(b * SEQ + lo + idx) * INW + OV + kvh * 64 + lane]);
    AY[(size_t)tok * DM + h * 64 + lane] = f2bf(o);
}

__global__ __launch_bounds__(256) void k_pool_v1(const bf16_t* __restrict__ U, const float* __restrict__ wg, const float* __restrict__ scale, bf16_t* __restrict__ AY) {
    const int tok = blockIdx.x, b = tok / SEQ, t = tok % SEQ;
    __shared__ float y[512];
    for (int c = threadIdx.x; c < 512; c += 256) {
        const int g = c >> 7, w = 2 << g, lo = max(t - w / 2, 0), hi = min(t + w / 2 - 1, SEQ - 1);
        float s = 0.f;
        for (int q = lo; q <= hi; ++q) s += bf2f(U[(size_t)(b * SEQ + q) * INW + OP + c]);
        y[c] = s / (float)(hi - lo + 1) - bf2f(U[(size_t)tok * INW + OP + c]);
    }
    __syncthreads();
    for (int o = threadIdx.x; o < 512; o += 256) {
        const int g = o >> 7, d = o & 127; float a = 0.f;
        for (int c = 0; c < 128; ++c) a += y[g * 128 + c] * wg[(size_t)(g * 128 + c) * 128 + d];
        AY[(size_t)tok * DM + 512 + o] = f2bf(a * scale[o]);
    }
}

__global__ __launch_bounds__(256) void k_ln_router_v1(const float* __restrict__ Z, const float* __restrict__ g1, const float* __restrict__ b1, const float* __restrict__ wr, const float* __restrict__ br,
                                                      bf16_t* __restrict__ H1B, float* __restrict__ STAT, int* cnt, int* te, float* tg, int* tr) {
    const int tok = blockIdx.x, tid = threadIdx.x, wave = tid >> 6, lane = tid & 63;
    __shared__ float hs[1024]; __shared__ float red[8]; __shared__ float lg[32];
    const f32x4 v = *(const f32x4*)(Z + (size_t)tok * DM + 4 * tid);
    float s = wave_sum((v[0] + v[1]) + (v[2] + v[3]));
    if (lane == 0) red[wave] = s;
    __syncthreads();
    const float mean = (red[0] + red[1] + red[2] + red[3]) * (1.0f / DM);
    const f32x4 d = v - mean;
    float q = wave_sum((d[0] * d[0] + d[1] * d[1]) + (d[2] * d[2] + d[3] * d[3]));
    if (lane == 0) red[4 + wave] = q;
    __syncthreads();
    const float rstd = rsqrtf((red[4] + red[5] + red[6] + red[7]) * (1.0f / DM) + LN_EPS);
    const f32x4 gg = *(const f32x4*)(g1 + 4 * tid), bb = *(const f32x4*)(b1 + 4 * tid);
    const f32x4 hv = d * rstd * gg + bb;
    *(f32x4*)(hs + 4 * tid) = hv;
    bf16_t* hb = H1B + (size_t)tok * DM + 4 * tid;
    hb[0] = f2bf(hv[0]); hb[1] = f2bf(hv[1]); hb[2] = f2bf(hv[2]); hb[3] = f2bf(hv[3]);
    if (tid == 0) { STAT[2 * tok] = mean; STAT[2 * tok + 1] = rstd; }
    __syncthreads();
    for (int e = 8 * wave; e < 8 * wave + 8; ++e) {
        float p = 0.f;
        for (int i = 0; i < 16; ++i) { const int c = lane + 64 * i; p += hs[c] * wr[(size_t)c * NE + e]; }
        p = wave_sum(p);
        if (lane == 0) lg[e] = p + br[e];
    }
    __syncthreads();
    if (tid == 0) {
        float sv[4]; int se[4];
#pragma unroll
        for (int k = 0; k < 4; ++k) {
            float best = -INFINITY; int bi = 0;
            for (int e = 0; e < NE; ++e) { const float x = lg[e]; if (x > best) { best = x; bi = e; } }
            sv[k] = best; se[k] = bi; lg[bi] = -INFINITY;
        }
        float ex[4], sum = 0.f;
#pragma unroll
        for (int k = 0; k < 4; ++k) { ex[k] = __expf(sv[k] - sv[0]); sum += ex[k]; }
#pragma unroll
        for (int k = 0; k < 4; ++k) {
            te[tok * 4 + k] = se[k]; tg[tok * 4 + k] = ex[k] / sum; tr[tok * 4 + k] = atomicAdd(&cnt[se[k]], 1);
        }
    }
}

__global__ void k_book(int* ctl) {
    if (threadIdx.x == 0) {
        int ps = 0;
        for (int e = 0; e < NE; ++e) { ctl[64 + e] = ps; const int nt = (ctl[e] + 255) >> 8; for (int i = 0; i < nt; ++i) ctl[256 + (ps >> 8) + i] = e; ps += nt << 8; }
        ctl[64 + NE] = ps; ctl[128] = ps >> 8;
    }
}

__global__ __launch_bounds__(128) void k_gather_v1(const bf16_t* __restrict__ H1B, const int* __restrict__ ctl, const int* __restrict__ te, const int* __restrict__ tr, int* __restrict__ td, bf16_t* __restrict__ XS) {
    const int a = blockIdx.x, tok = a >> 2;
    const int dest = ctl[64 + te[a]] + tr[a];
    if (threadIdx.x == 0) td[a] = dest;
    *(bf16x8*)(XS + (size_t)dest * DM + 8 * threadIdx.x) = *(const bf16x8*)(H1B + (size_t)tok * DM + 8 * threadIdx.x);
}

__global__ __launch_bounds__(256) void k_final_v1(const float* __restrict__ Z, const float* __restrict__ STAT, const float* __restrict__ g1, const float* __restrict__ b1, const bf16_t* __restrict__ YB,
                                                  const int* __restrict__ td, const float* __restrict__ tg, const float* __restrict__ g2, const float* __restrict__ b2, float* __restrict__ out) {
    const int tok = blockIdx.x, tid = threadIdx.x, wave = tid >> 6, lane = tid & 63;
    __shared__ float red[8];
    const f32x4 z = *(const f32x4*)(Z + (size_t)tok * DM + 4 * tid);
    const float mean1 = STAT[2 * tok], rstd1 = STAT[2 * tok + 1];
    const f32x4 h1 = (z - mean1) * rstd1 * *(const f32x4*)(g1 + 4 * tid) + *(const f32x4*)(b1 + 4 * tid);
    f32x4 f = (f32x4){0.f, 0.f, 0.f, 0.f};
#pragma unroll
    for (int k = 0; k < 4; ++k) {
        const bf16_t* yr = YB + (size_t)td[tok * 4 + k] * DM + 4 * tid; const float w = tg[tok * 4 + k];
        f[0] += w * bf2f(yr[0]); f[1] += w * bf2f(yr[1]); f[2] += w * bf2f(yr[2]); f[3] += w * bf2f(yr[3]);
    }
    const f32x4 v = ALPHA * h1 + f;
    float s = wave_sum((v[0] + v[1]) + (v[2] + v[3]));
    if (lane == 0) red[wave] = s;
    __syncthreads();
    const float mean = (red[0] + red[1] + red[2] + red[3]) * (1.0f / DM);
    const f32x4 d = v - mean;
    float q = wave_sum((d[0] * d[0] + d[1] * d[1]) + (d[2] * d[2] + d[3] * d[3]));
    if (lane == 0) red[4 + wave] = q;
    __syncthreads();
    const float rstd = rsqrtf((red[4] + red[5] + red[6] + red[7]) * (1.0f / DM) + LN_EPS);
    *(f32x4*)(out + (size_t)tok * DM + 4 * tid) = d * rstd * *(const f32x4*)(g2 + 4 * tid) + *(const f32x4*)(b2 + 4 * tid);
}

#define LAS __attribute__((address_space(3)))
typedef unsigned u32x4 __attribute__((ext_vector_type(4)));
typedef float f32x2 __attribute__((ext_vector_type(2)));
constexpr int NWAVES = 8;
constexpr int RING_BYTES = 131072;
constexpr int LDSX_OFF = RING_BYTES;
constexpr int LDS_BYTES = 147456;

__device__ __forceinline__ unsigned cvt_pk_bf16(float lo, float hi) { unsigned r; asm volatile("v_cvt_pk_bf16_f32 %0, %1, %2" : "=v"(r) : "v"(lo), "v"(hi)); return r; }
__device__ __forceinline__ float fast_sigmoid(float x) { return __builtin_amdgcn_rcpf(1.0f + __expf(-x)); }
__device__ __forceinline__ float bflo(unsigned w) { return __uint_as_float(w << 16); }
__device__ __forceinline__ float bfhi(unsigned w) { return __uint_as_float(w & 0xffff0000u); }

#define XB_TMO      128
#define XB_XCNT(j)  (256  + 64 * (j))
#define XB_XSUB(j)  (1280 + 64 * (j))
#define XB_XGEN(j)  (2304 + 64 * (j))
#define XB_TOP      3328
#define XB_TOPGEN   3392
#define XCD_BAR_WORDS 3456
#define XB_SPIN_CAP (1u << 18)
__device__ __forceinline__ unsigned xb_ld(unsigned* p)              { return __hip_atomic_load(p, __ATOMIC_RELAXED, __HIP_MEMORY_SCOPE_AGENT); }
__device__ __forceinline__ unsigned xb_add(unsigned* p, unsigned v) { return __hip_atomic_fetch_add(p, v, __ATOMIC_RELAXED, __HIP_MEMORY_SCOPE_AGENT); }
__device__ __forceinline__ unsigned xb_xcc_id() { return (unsigned)__builtin_amdgcn_s_getreg((3 << 11) | 20) & 0xFu; }
#define XB_SPIN(cond, bar) do { unsigned _sp = 0; while (cond) { __builtin_amdgcn_s_sleep(1); \
    if ((++_sp & 255u) == 0u) { if (xb_ld(&(bar)[XB_TMO])) break; if (_sp > XB_SPIN_CAP) { atomicAdd(&(bar)[XB_TMO], 1u); break; } } } } while (0)
struct XcdBarrier { unsigned* bar; unsigned x; volatile LAS unsigned* st; };
__device__ __forceinline__ XcdBarrier xcd_barrier_post(unsigned* bar, volatile LAS unsigned* st) {
    XcdBarrier b; b.bar = bar; b.x = xb_xcc_id(); b.st = st;
    if (threadIdx.x == 0) (void)xb_add(&bar[XB_XCNT(b.x)], 1u);
    return b;
}
__device__ __forceinline__ void xcd_barrier_complete(unsigned* bar, unsigned x, unsigned& nloc, unsigned& nx) {
    const unsigned G = gridDim.x * gridDim.y * gridDim.z;
    unsigned sum, cnt, mine, sp = 0u;
    for (;;) {
        sum = 0u; cnt = 0u; mine = 0u;
#pragma unroll
        for (unsigned j = 0; j < 16; ++j) { const unsigned c = xb_ld(&bar[XB_XCNT(j)]); sum += c; cnt += (c > 0u) ? 1u : 0u; mine = (j == x) ? c : mine; }
        if (sum == G) break;
        __builtin_amdgcn_s_sleep(1);
        if ((++sp & 255u) == 0u) { if (xb_ld(&bar[XB_TMO])) break; if (sp > XB_SPIN_CAP) { atomicAdd(&bar[XB_TMO], 1u); break; } }
    }
    nloc = mine > 0u ? mine : 1u; nx = cnt > 0u ? cnt : 1u;
}
__device__ __forceinline__ void xcd_barrier(const XcdBarrier& b) {
    asm volatile("s_waitcnt vmcnt(0)" ::: "memory");
    __syncthreads();
    if (threadIdx.x == 0) {
        unsigned* bar = b.bar;
        __builtin_amdgcn_s_waitcnt(0);
        unsigned nloc = b.st[0], nx = b.st[1];
        if (nloc == 0u) { xcd_barrier_complete(bar, b.x, nloc, nx); b.st[0] = nloc; b.st[1] = nx; }
        const unsigned old = xb_add(&bar[XB_XSUB(b.x)], 1u);
        const unsigned gen = old / nloc;
        if (old + 1u == (gen + 1u) * nloc) {
            __builtin_amdgcn_fence(__ATOMIC_RELEASE, "agent");
            asm volatile("s_waitcnt vmcnt(0)" ::: "memory");
            const unsigned og = xb_add(&bar[XB_TOP], 1u);
            const unsigned tg = og / nx;
            if (og + 1u == (tg + 1u) * nx) xb_add(&bar[XB_TOPGEN], 1u);
            else XB_SPIN(xb_ld(&bar[XB_TOPGEN]) == tg, bar);
            __builtin_amdgcn_fence(__ATOMIC_ACQUIRE, "agent");
            xb_add(&bar[XB_XGEN(b.x)], 1u);
            asm volatile("s_waitcnt vmcnt(0)" ::: "memory");
        } else {
            XB_SPIN(xb_ld(&bar[XB_XGEN(b.x)]) == gen, bar);
            __builtin_amdgcn_fence(__ATOMIC_ACQUIRE, "agent");
            asm volatile("s_waitcnt vmcnt(0)" ::: "memory");
        }
    }
    __syncthreads();
}

namespace pg8 {
constexpr int BM = 256, BK = 64, HALF = 128, HTB = HALF * BK * 2, STAGE_BYTES = 8 * HTB, NXCD = 8;
__host__ __device__ __forceinline__ int lds_byte(int r, int c) { const int st = (r >> 4) * 2 + (c >> 5), rr = r & 15, cc = c & 31, ob = rr * 64 + cc * 2; return st * 1024 + (ob ^ (((ob >> 9) & 1) << 5)); }
__host__ __device__ __forceinline__ void stage_rc(int b, int& R, int& C) { const int st = b / 1024, sb = b % 1024, swz = sb ^ (((sb >> 9) & 1) << 5); R = (st >> 1) * 16 + swz / 64; C = (st & 1) * 32 + (swz % 64) / 2; }
__host__ __device__ __forceinline__ int perm32(int rho) { const int n = rho >> 4, i = rho & 15; return 8 * (i >> 2) + 4 * n + (i & 3); }

struct Unit { int pm, pn, e; };
struct Gemm { const bf16_t* A; const bf16_t* Bt; int K, lda, ldb; size_t bstrideE; };

struct StaticOrder {
    int nM, nN, nwg, G, c, wgm;
    __device__ void init(int M, int N, int G_, int c_, int wgm_) { nM = M / BM; nN = N / BM; nwg = nM * nN; G = G_; c = c_; wgm = wgm_; }
    __device__ bool next(int i, Unit& u) const {
        const long L = (long)i * G + c; if (L >= nwg) return false;
        int wgid = (int)L; { const int q = nwg / NXCD, r = nwg % NXCD, xcd = wgid % NXCD, off = wgid / NXCD; wgid = (xcd < r ? xcd * (q + 1) : r * (q + 1) + (xcd - r) * q) + off; }
        const int nig = wgm * nN, gid = wgid / nig, fm = gid * wgm, gsz = (nM - fm) < wgm ? (nM - fm) : wgm;
        u.pm = fm + ((wgid % nig) % gsz); u.pn = (wgid % nig) / gsz; u.e = 0; return true;
    }
};
struct MoeOrder {
    int nT, nN, nwg, G, c; const LAS int* tile_e;
    __device__ bool next(int i, Unit& u) const {
        const long L = (long)i * G + c; if (L >= nwg) return false;
        int wgid = (int)L; { const int q = nwg / NXCD, r = nwg % NXCD, xcd = wgid % NXCD, off = wgid / NXCD; wgid = (xcd < r ? xcd * (q + 1) : r * (q + 1) + (xcd - r) * q) + off; }
        const int nig = 4 * nN, gid = wgid / nig, fm = gid * 4, gsz = (nT - fm) < 4 ? (nT - fm) : 4;
        u.pm = fm + ((wgid % nig) % gsz); u.pn = (wgid % nig) / gsz; u.e = tile_e[u.pm]; return true;
    }
};

typedef f32x4 Acc[2][2][4][2];

template <class Epi, class Sched, bool ALIGN_EPI>
__device__ __forceinline__ void gemm_phase(LAS unsigned char* lds, const Gemm g, const Sched& S, const Epi& E) {
    const int tid = threadIdx.x, wid = __builtin_amdgcn_readfirstlane(tid >> 6), lane = tid & 63, wr = wid >> 2, wc = wid & 3, fr = lane & 15, fq = lane >> 4;
    const int nt = g.K / BK;
    unsigned voffA[2], voffB[2];
#pragma unroll
    for (int i = 0; i < 2; ++i) { int R, C; stage_rc(tid * 16 + i * 8192, R, C); const int Rb = Epi::PERM ? ((R & ~31) + perm32(R & 31)) : R;
        voffA[i] = (unsigned)(R * g.lda + C) * 2u; voffB[i] = (unsigned)(Rb * g.ldb + C) * 2u; }
    const size_t kstep = (size_t)(BK * 2);
    const size_t hstepA = (size_t)HALF * g.lda * 2, hstepB = (size_t)HALF * g.ldb * 2;
    const size_t tstepA = 2 * hstepA, tstepB = 2 * hstepB;
    const unsigned ldsw = (unsigned)wid * 1024u;
    const int aoff = lds_byte(wr * 64 + fr, fq * 8), boff = lds_byte(wc * 32 + fr, fq * 8);
#define PG8_SA(b, h) (((b) * 2 + (h)) * HTB)
#define PG8_SB(b, h) ((4 + (b) * 2 + (h)) * HTB)
#define PG8_STAGE(bufoff, gbase, voff) do { _Pragma("unroll") for (int _i = 0; _i < 2; ++_i) \
        __builtin_amdgcn_global_load_lds((const unsigned*)((const char*)(gbase) + (voff)[_i]), (LAS unsigned*)(lds + (bufoff) + ldsw + _i * 8192), 16, 0, 0); } while (0)
#define PG8_LDA(dst, b, h) do { _Pragma("unroll") for (int m = 0; m < 4; ++m) _Pragma("unroll") for (int k = 0; k < 2; ++k) dst[m][k] = *(const LAS bf16x8*)(lds + PG8_SA(b, h) + aoff + m * 2048 + k * 1024); } while (0)
#define PG8_LDB(dst, b, h) do { _Pragma("unroll") for (int n = 0; n < 2; ++n) _Pragma("unroll") for (int k = 0; k < 2; ++k) dst[n][k] = *(const LAS bf16x8*)(lds + PG8_SB(b, h) + boff + n * 2048 + k * 1024); } while (0)
#define PG8_MMA(ai, bj, At, Bt) do { __builtin_amdgcn_s_setprio(1); _Pragma("unroll") for (int m = 0; m < 4; ++m) _Pragma("unroll") for (int n = 0; n < 2; ++n) _Pragma("unroll") for (int k = 0; k < 2; ++k) \
        acc[ai][bj][m][n] = __builtin_amdgcn_mfma_f32_16x16x32_bf16(Bt[n][k], At[m][k], acc[ai][bj][m][n], 0, 0, 0); __builtin_amdgcn_s_setprio(0); } while (0)
#define PG8_WAIT_V(n) asm volatile("s_waitcnt vmcnt(" #n ")" ::: "memory")
#define PG8_WAIT_L(n) asm volatile("s_waitcnt lgkmcnt(" #n ")" ::: "memory")
#define PG8_BAR __builtin_amdgcn_s_barrier()
#define PG8_SCHED __builtin_amdgcn_sched_barrier(0)
    Unit cur, nxt; int ui = 0;
    if (!S.next(0, cur)) return;
    Acc acc;
#pragma unroll
    for (int a = 0; a < 2; ++a)
#pragma unroll
        for (int b = 0; b < 2; ++b)
#pragma unroll
            for (int m = 0; m < 4; ++m)
#pragma unroll
                for (int n = 0; n < 2; ++n) acc[a][b][m][n] = (f32x4){0.f, 0.f, 0.f, 0.f};
    bf16x8 At[4][2], B0[2][2], B1[2][2];
    const char* cA = (const char*)g.A + (size_t)cur.pm * tstepA; const char* cB = (const char*)g.Bt + (size_t)cur.e * g.bstrideE + (size_t)cur.pn * tstepB;
    PG8_STAGE(PG8_SB(0, 0), cB, voffB); PG8_STAGE(PG8_SB(0, 1), cB + hstepB, voffB); PG8_STAGE(PG8_SA(0, 0), cA, voffA); PG8_STAGE(PG8_SA(0, 1), cA + hstepA, voffA);
    if (wr == 1) PG8_BAR;
    PG8_WAIT_V(2); PG8_BAR;
    PG8_STAGE(PG8_SB(1, 0), cB + kstep, voffB); PG8_STAGE(PG8_SA(1, 0), cA + kstep, voffA); PG8_STAGE(PG8_SB(1, 1), cB + hstepB + kstep, voffB);
    PG8_WAIT_V(6); PG8_BAR;
    for (;;) {
        const bool has_next = S.next(ui + 1, nxt);
        const char* nA = has_next ? (const char*)g.A + (size_t)nxt.pm * tstepA : cA;
        const char* nB = has_next ? (const char*)g.Bt + (size_t)nxt.e * g.bstrideE + (size_t)nxt.pn * tstepB : cB;
        for (int t = 0; t < nt; t += 2) {
            const bool last = (t == nt - 2);
            const char* a1 = cA + (size_t)(t + 1) * kstep;
            const char* a2 = last ? nA : cA + (size_t)(t + 2) * kstep; const char* b2 = last ? nB : cB + (size_t)(t + 2) * kstep;
            const char* a3 = a2 + kstep; const char* b3 = b2 + kstep;
            PG8_LDB(B0, 0, 0); PG8_LDB(B1, 0, 1); PG8_SCHED; PG8_LDA(At, 0, 0); PG8_STAGE(PG8_SA(1, 1), a1 + hstepA, voffA);
            PG8_WAIT_V(8); PG8_WAIT_L(0); PG8_BAR; PG8_MMA(0, 0, At, B0); PG8_MMA(0, 1, At, B1); PG8_BAR; PG8_SCHED;
            PG8_LDA(At, 0, 1); PG8_STAGE(PG8_SB(0, 0), b2, voffB); PG8_STAGE(PG8_SB(0, 1), b2 + hstepB, voffB); PG8_STAGE(PG8_SA(0, 0), a2, voffA);
            PG8_WAIT_V(8); PG8_WAIT_L(0); PG8_BAR; PG8_MMA(1, 0, At, B0); PG8_MMA(1, 1, At, B1); PG8_BAR; PG8_SCHED;
            PG8_LDB(B0, 1, 0); PG8_LDB(B1, 1, 1); PG8_SCHED; PG8_LDA(At, 1, 0); PG8_STAGE(PG8_SA(0, 1), a2 + hstepA, voffA);
            PG8_WAIT_V(8); PG8_WAIT_L(0); PG8_BAR; PG8_MMA(0, 0, At, B0); PG8_MMA(0, 1, At, B1); PG8_BAR; PG8_SCHED;
            PG8_LDA(At, 1, 1); PG8_STAGE(PG8_SB(1, 0), b3, voffB); PG8_STAGE(PG8_SB(1, 1), b3 + hstepB, voffB); PG8_STAGE(PG8_SA(1, 0), a3, voffA);
            PG8_WAIT_V(8); PG8_WAIT_L(0); PG8_BAR; PG8_MMA(1, 0, At, B0); PG8_MMA(1, 1, At, B1); PG8_BAR; PG8_SCHED;
        }
        if constexpr (ALIGN_EPI) { if (wr == 0) PG8_BAR; }
        E(acc, cur, wr, wc, fr, fq);
        if (!has_next) break;
#pragma unroll
        for (int a = 0; a < 2; ++a)
#pragma unroll
            for (int b = 0; b < 2; ++b)
#pragma unroll
                for (int m = 0; m < 4; ++m)
#pragma unroll
                    for (int n = 0; n < 2; ++n) acc[a][b][m][n] = (f32x4){0.f, 0.f, 0.f, 0.f};
        cur = nxt; cA = nA; cB = nB; ++ui;
        if constexpr (ALIGN_EPI) { if (wr == 1) PG8_BAR; }
    }
    PG8_WAIT_V(0);
    if constexpr (!ALIGN_EPI) { if (wr == 0) PG8_BAR; }
    PG8_BAR;
#undef PG8_SA
#undef PG8_SB
#undef PG8_STAGE
#undef PG8_LDA
#undef PG8_LDB
#undef PG8_MMA
#undef PG8_WAIT_V
#undef PG8_WAIT_L
#undef PG8_BAR
#undef PG8_SCHED
}

__device__ __forceinline__ u32x4 pack8(const f32x4 v0, const f32x4 v1) { u32x4 w; w.x = cvt_pk_bf16(v0[0], v0[1]); w.y = cvt_pk_bf16(v0[2], v0[3]); w.z = cvt_pk_bf16(v1[0], v1[1]); w.w = cvt_pk_bf16(v1[2], v1[3]); return w; }
__device__ __forceinline__ void unpack8(const u32x4 w, f32x4& v0, f32x4& v1) { v0 = (f32x4){bflo(w.x), bfhi(w.x), bflo(w.y), bfhi(w.y)}; v1 = (f32x4){bflo(w.z), bfhi(w.z), bflo(w.w), bfhi(w.w)}; }

struct EpiU { static constexpr bool PERM = true; bf16_t* U;
    __device__ __forceinline__ void operator()(const Acc& acc, const Unit& u, int wr, int wc, int fr, int fq) const {
        const int row0 = u.pm * BM + wr * 64 + fr, col0 = u.pn * BM + wc * 32 + 8 * fq;
        const int mode = u.pn < 2 ? 1 : (u.pn >= 5 ? 2 : 0);
#pragma unroll
        for (int ai = 0; ai < 2; ++ai)
#pragma unroll
            for (int m = 0; m < 4; ++m) { bf16_t* rowp = U + (size_t)(row0 + ai * HALF + m * 16) * INW + col0;
#pragma unroll
                for (int bj = 0; bj < 2; ++bj) { f32x4 v0 = acc[ai][bj][m][0], v1 = acc[ai][bj][m][1];
                    if (mode == 1) { v0 = v0 * 0.125f; v1 = v1 * 0.125f; }
                    else if (mode == 2) {
#pragma unroll
                        for (int j = 0; j < 4; ++j) { v0[j] = fast_sigmoid(v0[j]); v1[j] = fast_sigmoid(v1[j]); } }
                    *(u32x4*)(rowp + bj * HALF) = pack8(v0, v1); } }
    } };
struct EpiBrA { static constexpr bool PERM = true; const bf16_t* U; float* T;
    __device__ __forceinline__ void operator()(const Acc& acc, const Unit& u, int wr, int wc, int fr, int fq) const {
        const int row0 = u.pm * BM + wr * 64 + fr, col0 = u.pn * BM + wc * 32 + 8 * fq;
#pragma unroll
        for (int ai = 0; ai < 2; ++ai)
#pragma unroll
            for (int m = 0; m < 4; ++m) { const size_t row = (size_t)(row0 + ai * HALF + m * 16);
#pragma unroll
                for (int bj = 0; bj < 2; ++bj) { const int col = col0 + bj * HALF; f32x4 g0, g1; unpack8(*(const u32x4*)(U + row * INW + OGA + col), g0, g1);
                    float* tp = T + row * DM + col; *(f32x4*)tp = g0 * acc[ai][bj][m][0]; *(f32x4*)(tp + 4) = g1 * acc[ai][bj][m][1]; } }
    } };
struct EpiBrP { static constexpr bool PERM = true; const bf16_t* U; const float* T; bf16_t* MIX;
    __device__ __forceinline__ void operator()(const Acc& acc, const Unit& u, int wr, int wc, int fr, int fq) const {
        const int row0 = u.pm * BM + wr * 64 + fr, col0 = u.pn * BM + wc * 32 + 8 * fq;
#pragma unroll
        for (int ai = 0; ai < 2; ++ai)
#pragma unroll
            for (int m = 0; m < 4; ++m) { const size_t row = (size_t)(row0 + ai * HALF + m * 16);
#pragma unroll
                for (int bj = 0; bj < 2; ++bj) { const int col = col0 + bj * HALF; f32x4 g0, g1; unpack8(*(const u32x4*)(U + row * INW + OGP + col), g0, g1);
                    const float* tp = T + row * DM + col; const f32x4 t0 = *(const f32x4*)tp, t1 = *(const f32x4*)(tp + 4);
                    *(u32x4*)(MIX + row * DM + col) = pack8(t0 + g0 * acc[ai][bj][m][0], t1 + g1 * acc[ai][bj][m][1]); } }
    } };
struct EpiZ { static constexpr bool PERM = false; const float* x; float* Z;
    __device__ __forceinline__ void operator()(const Acc& acc, const Unit& u, int wr, int wc, int fr, int fq) const {
        const int row0 = u.pm * BM + wr * 64 + fr, col0 = u.pn * BM + wc * 32 + 4 * fq;
#pragma unroll
        for (int ai = 0; ai < 2; ++ai)
#pragma unroll
            for (int m = 0; m < 4; ++m) { const size_t off = (size_t)(row0 + ai * HALF + m * 16) * DM + col0;
#pragma unroll
                for (int bj = 0; bj < 2; ++bj)
#pragma unroll
                    for (int n = 0; n < 2; ++n) { const f32x4 xv = *(const f32x4*)(x + off + bj * HALF + n * 16); *(f32x4*)(Z + off + bj * HALF + n * 16) = xv * ALPHA + acc[ai][bj][m][n]; } }
    } };
struct EpiAct { static constexpr bool PERM = true; const float* b1; bf16_t* ACT;
    __device__ __forceinline__ void operator()(const Acc& acc, const Unit& u, int wr, int wc, int fr, int fq) const {
        const int row0 = u.pm * BM + wr * 64 + fr, j0 = u.pn * HALF + wc * 32 + 8 * fq;
        const float* bp = b1 + (size_t)u.e * 2 * DE + j0;
        const f32x4 bg0 = *(const f32x4*)bp, bg1 = *(const f32x4*)(bp + 4), bu0 = *(const f32x4*)(bp + DE), bu1 = *(const f32x4*)(bp + DE + 4);
#pragma unroll
        for (int ai = 0; ai < 2; ++ai)
#pragma unroll
            for (int m = 0; m < 4; ++m) {
                f32x4 o[2];
#pragma unroll
                for (int n = 0; n < 2; ++n) { const f32x4 hg = acc[ai][0][m][n] + (n ? bg1 : bg0), hu = acc[ai][1][m][n] + (n ? bu1 : bu0);
#pragma unroll
                    for (int j = 0; j < 4; ++j) { const float gate = fminf(hg[j], 7.0f), up = fminf(fmaxf(hu[j], -7.0f), 7.0f); o[n][j] = (up + 1.0f) * gate * fast_sigmoid(1.702f * gate); } }
                *(u32x4*)(ACT + (size_t)(row0 + ai * HALF + m * 16) * DE + j0) = pack8(o[0], o[1]); }
    } };
struct EpiY { static constexpr bool PERM = true; const float* b2; bf16_t* YB;
    __device__ __forceinline__ void operator()(const Acc& acc, const Unit& u, int wr, int wc, int fr, int fq) const {
        const int row0 = u.pm * BM + wr * 64 + fr, col0 = u.pn * BM + wc * 32 + 8 * fq;
        const float* bp = b2 + (size_t)u.e * DM + col0;
        f32x4 bv[2][2];
#pragma unroll
        for (int bj = 0; bj < 2; ++bj) { bv[bj][0] = *(const f32x4*)(bp + bj * HALF); bv[bj][1] = *(const f32x4*)(bp + bj * HALF + 4); }
#pragma unroll
        for (int ai = 0; ai < 2; ++ai)
#pragma unroll
            for (int m = 0; m < 4; ++m) { bf16_t* rowp = YB + (size_t)(row0 + ai * HALF + m * 16) * DM + col0;
#pragma unroll
                for (int bj = 0; bj < 2; ++bj) *(u32x4*)(rowp + bj * HALF) = pack8(acc[ai][bj][m][0] + bv[bj][0], acc[ai][bj][m][1] + bv[bj][1]); }
    } };
}

__device__ __forceinline__ void p0_item(const float* W, int N, int k0, int n0, bf16_t* WT, int ldt, int drow0, int dk0, LAS float* scr, int lane) {
#pragma unroll 8
    for (int i = 0; i < 32; ++i) { const int kk = 2 * i + (lane >> 5); scr[kk * 33 + (lane & 31)] = W[(size_t)(k0 + kk) * N + n0 + (lane & 31)]; }
    asm volatile("s_waitcnt lgkmcnt(0)" ::: "memory");
    const int c = lane & 7;
#pragma unroll
    for (int j = 0; j < 4; ++j) { const int n = (lane >> 3) + 8 * j; const LAS float* s = scr + (8 * c) * 33 + n;
        u32x4 o; o.x = cvt_pk_bf16(s[0 * 33], s[1 * 33]); o.y = cvt_pk_bf16(s[2 * 33], s[3 * 33]); o.z = cvt_pk_bf16(s[4 * 33], s[5 * 33]); o.w = cvt_pk_bf16(s[6 * 33], s[7 * 33]);
        *(u32x4*)(WT + (size_t)(drow0 + n) * ldt + dk0 + k0 + 8 * c) = o; }
    asm volatile("s_waitcnt lgkmcnt(0)" ::: "memory");
}

struct MArgs { const float* in[18]; float* out; unsigned char* ws; int ph_lo, ph_hi, li, pad; };

__global__ void __launch_bounds__(NWAVES * 64, 2) mega(MArgs a) {
    extern __shared__ __attribute__((aligned(16))) unsigned char lds_raw[];
    LAS unsigned char* lds = (LAS unsigned char*)lds_raw;
    volatile LAS unsigned* XW = (volatile LAS unsigned*)(lds + LDSX_OFF);
    const int tid = threadIdx.x, lane = tid & 63, wave = __builtin_amdgcn_readfirstlane(tid >> 6);
    const int G = gridDim.x, bx = blockIdx.x;
    const int vcu = (G % 8 == 0) ? (bx % 8) * (G / 8) + bx / 8 : bx;
    unsigned char* ws = a.ws;
    unsigned* ctl = (unsigned*)(ws + WS_CTL);
    bf16_t* U = (bf16_t*)(ws + WS_U); bf16_t* AY = (bf16_t*)(ws + WS_AY); bf16_t* MIX = (bf16_t*)(ws + WS_MIX); bf16_t* XB = (bf16_t*)(ws + WS_XB);
    float* Z = (float*)(ws + WS_Z); bf16_t* XS = (bf16_t*)(ws + WS_XS); bf16_t* ACT = (bf16_t*)(ws + WS_ACT); float* T = (float*)(ws + WS_ACT); bf16_t* YB = XS;
    bf16_t* Wint = (bf16_t*)(ws + WS_WIN); bf16_t* Wab = (bf16_t*)(ws + WS_WAB); bf16_t* Wot = (bf16_t*)(ws + WS_WO); bf16_t* W1t = (bf16_t*)(ws + WS_W1); bf16_t* W2t = (bf16_t*)(ws + WS_W2);
    if (tid < 16) XW[tid] = 0u;
    __syncthreads();
    XcdBarrier bar = xcd_barrier_post(ctl + CW_BAR + a.li * XCD_BAR_WORDS, XW);
    const int lo = a.ph_lo, hi = a.ph_hi;
#define IN(k) (lo <= (k) && (k) < hi)
#define SEAM(k) do { if (IN(k) && IN((k) + 1)) xcd_barrier(bar); } while (0)

    if (IN(0)) {
        LAS float* scr = (LAS float*)(lds + wave * 16384);
        const int gw = vcu * NWAVES + wave, NGW = G * NWAVES;
        constexpr int I_IN = (DM / 64) * (INW / 32), I_AB = (512 / 64) * (DM / 32), I_O = (DM / 64) * (DM / 32), I_1 = (DM / 64) * (2 * DE / 32), I_2 = (DE / 64) * (DM / 32);
        constexpr int NITEMS = I_IN + 2 * I_AB + I_O + NE * (I_1 + I_2);
        for (int it = gw; it < NITEMS; it += NGW) {
            int r = it;
            if (r < I_IN) { const int nb = INW / 32; p0_item(a.in[1], INW, 64 * (r / nb), 32 * (r % nb), Wint, DM, 32 * (r % nb), 0, scr, lane); continue; } r -= I_IN;
            if (r < I_AB) { const int nb = DM / 32; p0_item(a.in[3], DM, 64 * (r / nb), 32 * (r % nb), Wab, DM, 32 * (r % nb), 0, scr, lane); continue; } r -= I_AB;
            if (r < I_AB) { const int nb = DM / 32; p0_item(a.in[6], DM, 64 * (r / nb), 32 * (r % nb), Wab, DM, 32 * (r % nb), 512, scr, lane); continue; } r -= I_AB;
            if (r < I_O) { const int nb = DM / 32; p0_item(a.in[7], DM, 64 * (r / nb), 32 * (r % nb), Wot, DM, 32 * (r % nb), 0, scr, lane); continue; } r -= I_O;
            if (r < NE * I_1) { const int e = r / I_1, q = r % I_1, nb = 2 * DE / 32, n0 = 32 * (q % nb);
                const int drow = n0 < DE ? 256 * (n0 >> 7) + (n0 & 127) : 256 * ((n0 - DE) >> 7) + 128 + ((n0 - DE) & 127);
                p0_item(a.in[12] + (size_t)e * DM * 2 * DE, 2 * DE, 64 * (q / nb), n0, W1t + (size_t)e * 2 * DE * DM, DM, drow, 0, scr, lane); continue; } r -= NE * I_1;
            { const int e = r / I_2, q = r % I_2, nb = DM / 32; p0_item(a.in[14] + (size_t)e * DE * DM, DM, 64 * (q / nb), 32 * (q % nb), W2t + (size_t)e * DM * DE, DE, 32 * (q % nb), 0, scr, lane); }
        }
        const float* x = a.in[0];
        for (size_t i = ((size_t)gw * 64 + lane) * 8; i < (size_t)NTOK * DM; i += (size_t)NGW * 64 * 8) {
            const f32x4 v0 = *(const f32x4*)(x + i), v1 = *(const f32x4*)(x + i + 4);
            *(u32x4*)(XB + i) = pg8::pack8(v0, v1); }
    }
    SEAM(0);
    if (IN(1)) {
        pg8::Gemm g{XB, Wint, DM, DM, DM, 0}; pg8::StaticOrder S; S.init(NTOK, INW, G, bx, 8);
        pg8::gemm_phase<pg8::EpiU, pg8::StaticOrder, true>(lds, g, S, pg8::EpiU{U});
    }
    SEAM(1);
    SEAM(2);
    if (IN(3)) {
        pg8::StaticOrder S; S.init(NTOK, DM, G, bx, 8);
        { pg8::Gemm g{AY, Wab, 512, DM, DM, 0}; pg8::gemm_phase<pg8::EpiBrA, pg8::StaticOrder, true>(lds, g, S, pg8::EpiBrA{U, T}); }
        asm volatile("s_waitcnt vmcnt(0)" ::: "memory"); __syncthreads();
        { pg8::Gemm g{AY + 512, Wab + 512, 512, DM, DM, 0}; pg8::gemm_phase<pg8::EpiBrP, pg8::StaticOrder, true>(lds, g, S, pg8::EpiBrP{U, T, MIX}); }
    }
    SEAM(3);
    if (IN(4)) {
        pg8::Gemm g{MIX, Wot, DM, DM, DM, 0}; pg8::StaticOrder S; S.init(NTOK, DM, G, bx, 8);
        pg8::gemm_phase<pg8::EpiZ, pg8::StaticOrder, true>(lds, g, S, pg8::EpiZ{a.in[0], Z});
    }
    SEAM(4);
    SEAM(5);
    SEAM(6);
    if (IN(7) || IN(8)) {
        LAS int* tile_e = (LAS int*)(lds + LDSX_OFF + 256);
        if (tid == 0) { int ps = 0; for (int e = 0; e < NE; ++e) { const int nt = ((int)ctl[e] + 255) >> 8; for (int i = 0; i < nt; ++i) tile_e[1 + ps + i] = e; ps += nt; } tile_e[0] = ps; }
        __syncthreads();
        const int nT = tile_e[0];
        if (IN(7)) {
            pg8::Gemm g{XS, W1t, DM, DM, DM, (size_t)2 * DE * DM * 2}; pg8::MoeOrder S{nT, DE / 128, nT * (DE / 128), G, bx, tile_e + 1};
            pg8::gemm_phase<pg8::EpiAct, pg8::MoeOrder, true>(lds, g, S, pg8::EpiAct{a.in[13], ACT});
        }
        SEAM(7);
        if (IN(8)) {
            pg8::Gemm g{ACT, W2t, DE, DE, DE, (size_t)DM * DE * 2}; pg8::MoeOrder S{nT, DM / 256, nT * (DM / 256), G, bx, tile_e + 1};
            pg8::gemm_phase<pg8::EpiY, pg8::MoeOrder, true>(lds, g, S, pg8::EpiY{a.in[15], YB});
        }
    }
#undef IN
#undef SEAM
}

extern "C" void kernel_launch(void* const* d_in, const int* in_sizes, int n_in, void* d_out, int out_size, void* d_ws, size_t ws_size, hipStream_t stream) {
    static int grid = 0;
    if (grid == 0) {
        if (n_in != 18 || ws_size < WS_END) { fprintf(stderr, "kernel_launch: unexpected n_in %d / ws_size %zu (need %zu)\n", n_in, ws_size, (size_t)WS_END); grid = -1; return; }
        int dev = 0, cus = 0;
        if (hipGetDevice(&dev) != hipSuccess || hipDeviceGetAttribute(&cus, hipDeviceAttributeMultiprocessorCount, dev) != hipSuccess) { grid = -1; return; }
        if (hipFuncSetAttribute((const void*)mega, hipFuncAttributeMaxDynamicSharedMemorySize, LDS_BYTES) != hipSuccess) { fprintf(stderr, "kernel_launch: hipFuncSetAttribute failed\n"); grid = -1; return; }
        grid = cus;
    }
    if (grid < 0) return;
    const float* x = (const float*)d_in[0]; const float* sinks = (const float*)d_in[2];
    const float* w_pg = (const float*)d_in[4]; const float* pscale = (const float*)d_in[5];
    const float* ln1g = (const float*)d_in[8]; const float* ln1b = (const float*)d_in[9]; const float* w_r = (const float*)d_in[10]; const float* b_r = (const float*)d_in[11];
    const float* ln2g = (const float*)d_in[16]; const float* ln2b = (const float*)d_in[17];
    char* ws = (char*)d_ws; float* out = (float*)d_out;
    int* ctl = (int*)(ws + WS_CTL); bf16_t* U = (bf16_t*)(ws + WS_U); bf16_t* AY = (bf16_t*)(ws + WS_AY);
    bf16_t* H1B = (bf16_t*)(ws + WS_H1B); float* Z = (float*)(ws + WS_Z); float* STAT = (float*)(ws + WS_STAT);
    int* te = (int*)(ws + WS_TE); float* tg = (float*)(ws + WS_TG); int* tr = (int*)(ws + WS_TR); int* td = (int*)(ws + WS_TD);
    bf16_t* XS = (bf16_t*)(ws + WS_XS); bf16_t* YB = XS;
    (void)x; (void)in_sizes; (void)out_size;

    if (hipMemsetAsync(ctl, 0, CTL_BYTES, stream) != hipSuccess) return;
    MArgs a{};
    for (int i = 0; i < 18; ++i) a.in[i] = (const float*)d_in[i];
    a.out = out; a.ws = (unsigned char*)d_ws;
    a.ph_lo = 0; a.ph_hi = 2; a.li = 0;
    hipLaunchKernelGGL(mega, dim3(grid), dim3(NWAVES * 64), LDS_BYTES, stream, a);
    k_attn_v1<<<NTOK * 8, 64, 0, stream>>>(U, sinks, AY);
    k_pool_v1<<<NTOK, 256, 0, stream>>>(U, w_pg, pscale, AY);
    a.ph_lo = 3; a.ph_hi = 5; a.li = 1;
    hipLaunchKernelGGL(mega, dim3(grid), dim3(NWAVES * 64), LDS_BYTES, stream, a);
    k_ln_router_v1<<<NTOK, 256, 0, stream>>>(Z, ln1g, ln1b, w_r, b_r, H1B, STAT, ctl, te, tg, tr);
    k_book<<<1, 64, 0, stream>>>(ctl);
    k_gather_v1<<<NTOK * 4, 128, 0, stream>>>(H1B, ctl, te, tr, td, XS);
    a.ph_lo = 7; a.ph_hi = 9; a.li = 2;
    hipLaunchKernelGGL(mega, dim3(grid), dim3(NWAVES * 64), LDS_BYTES, stream, a);
    k_final_v1<<<NTOK, 256, 0, stream>>>(Z, STAT, ln1g, ln1b, YB, td, tg, ln2g, ln2b, out);
}
```

```cpp
#include <hip/hip_runtime.h>
#include <stdint.h>
#include <cstdio>

typedef unsigned short bf16_t;
typedef short bf16x8 __attribute__((ext_vector_type(8)));
typedef float f32x4 __attribute__((ext_vector_type(4)));

constexpr int NTOK = 16384, DM = 1024, SEQ = 8192, INW = 3328;
constexpr int OQ = 0, OKK = 512, OV = 640, OP = 768, OGA = 1280, OGP = 2304;
constexpr int NE = 32, TOPK = 4, DE = 1024;
constexpr int MAXROWS = NTOK * TOPK + NE * 256;
constexpr int MAXTILES = MAXROWS / 256;
constexpr float ALPHA = 1.189207115002721f;
constexpr float LN_EPS = 1e-5f;

constexpr size_t WS_CTL = 0, CTL_BYTES = 262144;
constexpr size_t WS_U = CTL_BYTES;
constexpr size_t SZ_U = (size_t)NTOK * INW * 2;
constexpr size_t SZ_A16 = (size_t)NTOK * DM * 2;
constexpr size_t WS_AY = WS_U + SZ_U;
constexpr size_t WS_MIX = WS_AY + SZ_A16;
constexpr size_t WS_H1B = WS_MIX + SZ_A16;
constexpr size_t WS_XB = WS_H1B + SZ_A16;
constexpr size_t WS_Z = WS_XB + SZ_A16;
constexpr size_t WS_STAT = WS_Z + (size_t)NTOK * DM * 4;
constexpr size_t WS_TE = WS_STAT + (size_t)NTOK * 8;
constexpr size_t WS_TG = WS_TE + (size_t)NTOK * 16;
constexpr size_t WS_TR = WS_TG + (size_t)NTOK * 16;
constexpr size_t WS_TD = WS_TR + (size_t)NTOK * 16;
constexpr size_t WS_XS = WS_TD + (size_t)NTOK * 16;
constexpr size_t SZ_XS = (size_t)MAXROWS * DM * 2;
constexpr size_t WS_ACT = WS_XS + SZ_XS;
constexpr size_t WS_WIN = WS_ACT + SZ_XS;
constexpr size_t WS_WAB = WS_WIN + (size_t)INW * DM * 2;
constexpr size_t WS_WO = WS_WAB + (size_t)DM * DM * 2;
constexpr size_t WS_WG = WS_WO + (size_t)DM * DM * 2;
constexpr size_t WS_W1 = WS_WG + (size_t)4 * 128 * 128 * 2;
constexpr size_t WS_W2 = WS_W1 + (size_t)NE * 2 * DE * DM * 2;
constexpr size_t WS_WR = WS_W2 + (size_t)NE * DE * DM * 2;
constexpr size_t WS_END = WS_WR + (size_t)NE * DM * 4 + 256;
constexpr int CW_BAR = 4096;

__device__ __forceinline__ bf16_t f2bf(float f) { uint32_t u = __float_as_uint(f); u += 0x7fffu + ((u >> 16) & 1u); return (bf16_t)(u >> 16); }
__device__ __forceinline__ float bf2f(bf16_t b) { return __uint_as_float(((uint32_t)b) << 16); }
__device__ __forceinline__ float sigmoidf_(float x) { return 1.0f / (1.0f + __expf(-x)); }

__device__ __forceinline__ float wave_sum(float v) {
#pragma unroll
    for (int o = 1; o < 64; o <<= 1) v += __shfl_xor(v, o);
    return v;
}
__device__ __forceinline__ float wave_max(float v) {
#pragma unroll
    for (int o = 1; o < 64; o <<= 1) v = fmaxf(v, __shfl_xor(v, o));
    return v;
}

__global__ __launch_bounds__(256) void k_xconv(const float* __restrict__ x, bf16_t* __restrict__ xb) {
    size_t i = ((size_t)blockIdx.x * 256 + threadIdx.x) * 8;
    f32x4 a = *(const f32x4*)(x + i), b = *(const f32x4*)(x + i + 4);
    bf16x8 o;
    o[0] = f2bf(a[0]); o[1] = f2bf(a[1]); o[2] = f2bf(a[2]); o[3] = f2bf(a[3]);
    o[4] = f2bf(b[0]); o[5] = f2bf(b[1]); o[6] = f2bf(b[2]); o[7] = f2bf(b[3]);
    *(bf16x8*)(xb + i) = o;
}

struct GemmArgs { const bf16_t* A; const float* B; const int* tile_e; const int* ntiles; size_t bstrideE; int lda, ldb, K, dualoff; };

template <class Epi, bool DUAL>
__global__ __launch_bounds__(256) void gemm_v1(GemmArgs g, Epi epi) {
    const int wave = threadIdx.x >> 6, l = threadIdx.x & 63, fr = l & 15, fq = l >> 4;
    const int m0 = blockIdx.y * 64, n0 = blockIdx.x * 64 + wave * 16;
    const float* B = g.B; int e = 0;
    if (g.tile_e) { if ((m0 >> 8) >= *g.ntiles) return; e = g.tile_e[m0 >> 8]; B += (size_t)e * g.bstrideE; }
    f32x4 acc[4], acc2[4];
#pragma unroll
    for (int i = 0; i < 4; ++i) { acc[i] = (f32x4){0.f, 0.f, 0.f, 0.f}; acc2[i] = (f32x4){0.f, 0.f, 0.f, 0.f}; }
    for (int k0 = 0; k0 < g.K; k0 += 32) {
        bf16x8 b, b2;
#pragma unroll
        for (int j = 0; j < 8; ++j) {
            const float* bp = B + (size_t)(k0 + 8 * fq + j) * g.ldb + n0 + fr;
            b[j] = (short)f2bf(bp[0]);
            if (DUAL) b2[j] = (short)f2bf(bp[g.dualoff]);
        }
#pragma unroll
        for (int i = 0; i < 4; ++i) {
            const bf16x8 a = *(const bf16x8*)(g.A + (size_t)(m0 + 16 * i + fr) * g.lda + k0 + 8 * fq);
            acc[i] = __builtin_amdgcn_mfma_f32_16x16x32_bf16(a, b, acc[i], 0, 0, 0);
            if (DUAL) acc2[i] = __builtin_amdgcn_mfma_f32_16x16x32_bf16(a, b2, acc2[i], 0, 0, 0);
        }
    }
#pragma unroll
    for (int i = 0; i < 4; ++i)
#pragma unroll
        for (int r = 0; r < 4; ++r) epi(m0 + 16 * i + 4 * fq + r, n0 + fr, acc[i][r], acc2[i][r], e);
}

struct EpiInproj { bf16_t* U;
    __device__ void operator()(int row, int col, float v, float, int) const {
        float o = v;
        if (col < OKK) o = v * 0.125f; else if (col >= OGA) o = sigmoidf_(v);
        U[(size_t)row * INW + col] = f2bf(o); } };
struct EpiBrA { const bf16_t* U; float* T;
    __device__ void operator()(int row, int col, float v, float, int) const { T[(size_t)row * DM + col] = bf2f(U[(size_t)row * INW + OGA + col]) * v; } };
struct EpiBrP { const bf16_t* U; const float* T; bf16_t* MIX;
    __device__ void operator()(int row, int col, float v, float, int) const { MIX[(size_t)row * DM + col] = f2bf(T[(size_t)row * DM + col] + bf2f(U[(size_t)row * INW + OGP + col]) * v); } };
struct EpiOut { const float* x; float* Z;
    __device__ void operator()(int row, int col, float v, float, int) const { Z[(size_t)row * DM + col] = ALPHA * x[(size_t)row * DM + col] + v; } };
struct EpiMlp1 { const float* b1; bf16_t* ACT;
    __device__ void operator()(int row, int col, float vg, float vu, int e) const {
        vg += b1[(size_t)e * 2 * DE + col]; vu += b1[(size_t)e * 2 * DE + DE + col];
        const float gate = fminf(vg, 7.0f), up = fminf(fmaxf(vu, -7.0f), 7.0f);
        ACT[(size_t)row * DE + col] = f2bf((up + 1.0f) * gate * sigmoidf_(1.702f * gate)); } };
struct EpiMlp2 { const float* b2; bf16_t* YB;
    __device__ void operator()(int row, int col, float v, float, int e) const { YB[(size_t)row * DM + col] = f2bf(v + b2[(size_t)e * DM + col]); } };

__global__ __launch_bounds__(64) void k_attn_v1(const bf16_t* __restrict__ U, const float* __restrict__ sinks, bf16_t* __restrict__ AY) {
    const int tok = blockIdx.x >> 3, h = blockIdx.x & 7, b = tok / SEQ, t = tok % SEQ, kvh = h >> 2, lane = threadIdx.x;
    __shared__ float pbuf[320]; __shared__ float qs[64];
    qs[lane] = bf2f(U[(size_t)tok * INW + OQ + h * 64 + lane]);
    __syncthreads();
    const int lo = max(t - 128, 0), hi = min(t + 128, SEQ - 1), nk = hi - lo + 1;
    const float slope = exp2f(-(float)(h + 1)), sink = sinks[h];
    float sc[5]; float mx = -INFINITY;
#pragma unroll
    for (int i = 0; i < 5; ++i) {
        const int idx = lane + 64 * i; sc[i] = -INFINITY;
        if (idx < nk) {
            const int s = lo + idx; const bf16_t* kr = U + (size_t)(b * SEQ + s) * INW + OKK + kvh * 64; float d = 0.f;
            for (int c = 0; c < 64; ++c) d += qs[c] * bf2f(kr[c]);
            sc[i] = d - slope * fabsf((float)(s - t)); mx = fmaxf(mx, sc[i]);
        }
    }
    const float m = fmaxf(wave_max(mx), sink);
    float ps = 0.f;
#pragma unroll
    for (int i = 0; i < 5; ++i) { sc[i] = __expf(sc[i] - m); ps += sc[i]; }
    const float inv = 1.0f / (wave_sum(ps) + __expf(sink - m));
#pragma unroll
    for (int i = 0; i < 5; ++i) { const int idx = lane + 64 * i; if (idx < 320) pbuf[idx] = sc[i] * inv; }
    __syncthreads();
    float o = 0.f;
    for (int idx = 0; idx < nk; ++idx) o += pbuf[idx] * bf2f(U[(size_t)(b * SEQ + lo + idx) * INW + OV + kvh * 64 + lane]);
    AY[(size_t)tok * DM + h * 64 + lane] = f2bf(o);
}

__global__ __launch_bounds__(256) void k_pool_v1(const bf16_t* __restrict__ U, const float* __restrict__ wg, const float* __restrict__ scale, bf16_t* __restrict__ AY) {
    const int tok = blockIdx.x, b = tok / SEQ, t = tok % SEQ;
    __shared__ float y[512];
    for (int c = threadIdx.x; c < 512; c += 256) {
        const int g = c >> 7, w = 2 << g, lo = max(t - w / 2, 0), hi = min(t + w / 2 - 1, SEQ - 1);
        float s = 0.f;
        for (int q = lo; q <= hi; ++q) s += bf2f(U[(size_t)(b * SEQ + q) * INW + OP + c]);
        y[c] = s / (float)(hi - lo + 1) - bf2f(U[(size_t)tok * INW + OP + c]);
    }
    __syncthreads();
    for (int o = threadIdx.x; o < 512; o += 256) {
        const int g = o >> 7, d = o & 127; float a = 0.f;
        for (int c = 0; c < 128; ++c) a += y[g * 128 + c] * wg[(size_t)(g * 128 + c) * 128 + d];
        AY[(size_t)tok * DM + 512 + o] = f2bf(a * scale[o]);
    }
}

__global__ __launch_bounds__(256) void k_ln_router_v1(const float* __restrict__ Z, const float* __restrict__ g1, const float* __restrict__ b1, const float* __restrict__ wr, const float* __restrict__ br,
                                                      bf16_t* __restrict__ H1B, float* __restrict__ STAT, int* cnt, int* te, float* tg, int* tr) {
    const int tok = blockIdx.x, tid = threadIdx.x, wave = tid >> 6, lane = tid & 63;
    __shared__ float hs[1024]; __shared__ float red[8]; __shared__ float lg[32];
    const f32x4 v = *(const f32x4*)(Z + (size_t)tok * DM + 4 * tid);
    float s = wave_sum((v[0] + v[1]) + (v[2] + v[3]));
    if (lane == 0) red[wave] = s;
    __syncthreads();
    const float mean = (red[0] + red[1] + red[2] + red[3]) * (1.0f / DM);
    const f32x4 d = v - mean;
    float q = wave_sum((d[0] * d[0] + d[1] * d[1]) + (d[2] * d[2] + d[3] * d[3]));
    if (lane == 0) red[4 + wave] = q;
    __syncthreads();
    const float rstd = rsqrtf((red[4] + red[5] + red[6] + red[7]) * (1.0f / DM) + LN_EPS);
    const f32x4 gg = *(const f32x4*)(g1 + 4 * tid), bb = *(const f32x4*)(b1 + 4 * tid);
    const f32x4 hv = d * rstd * gg + bb;
    *(f32x4*)(hs + 4 * tid) = hv;
    bf16_t* hb = H1B + (size_t)tok * DM + 4 * tid;
    hb[0] = f2bf(hv[0]); hb[1] = f2bf(hv[1]); hb[2] = f2bf(hv[2]); hb[3] = f2bf(hv[3]);
    if (tid == 0) { STAT[2 * tok] = mean; STAT[2 * tok + 1] = rstd; }
    __syncthreads();
    for (int e = 8 * wave; e < 8 * wave + 8; ++e) {
        float p = 0.f;
        for (int i = 0; i < 16; ++i) { const int c = lane + 64 * i; p += hs[c] * wr[(size_t)c * NE + e]; }
        p = wave_sum(p);
        if (lane == 0) lg[e] = p + br[e];
    }
    __syncthreads();
    if (tid == 0) {
        float sv[4]; int se[4];
#pragma unroll
        for (int k = 0; k < 4; ++k) {
            float best = -INFINITY; int bi = 0;
            for (int e = 0; e < NE; ++e) { const float x = lg[e]; if (x > best) { best = x; bi = e; } }
            sv[k] = best; se[k] = bi; lg[bi] = -INFINITY;
        }
        float ex[4], sum = 0.f;
#pragma unroll
        for (int k = 0; k < 4; ++k) { ex[k] = __expf(sv[k] - sv[0]); sum += ex[k]; }
#pragma unroll
        for (int k = 0; k < 4; ++k) {
            te[tok * 4 + k] = se[k]; tg[tok * 4 + k] = ex[k] / sum; tr[tok * 4 + k] = atomicAdd(&cnt[se[k]], 1);
        }
    }
}

__global__ void k_book(int* ctl) {
    if (threadIdx.x == 0) {
        int ps = 0;
        for (int e = 0; e < NE; ++e) { ctl[64 + e] = ps; const int nt = (ctl[e] + 255) >> 8; for (int i = 0; i < nt; ++i) ctl[256 + (ps >> 8) + i] = e; ps += nt << 8; }
        ctl[64 + NE] = ps; ctl[128] = ps >> 8;
    }
}

__global__ __launch_bounds__(128) void k_gather_v1(const bf16_t* __restrict__ H1B, const int* __restrict__ ctl, const int* __restrict__ te, const int* __restrict__ tr, int* __restrict__ td, bf16_t* __restrict__ XS) {
    const int a = blockIdx.x, tok = a >> 2;
    const int dest = ctl[64 + te[a]] + tr[a];
    if (threadIdx.x == 0) td[a] = dest;
    *(bf16x8*)(XS + (size_t)dest * DM + 8 * threadIdx.x) = *(const bf16x8*)(H1B + (size_t)tok * DM + 8 * threadIdx.x);
}

__global__ __launch_bounds__(256) void k_final_v1(const float* __restrict__ Z, const float* __restrict__ STAT, const float* __restrict__ g1, const float* __restrict__ b1, const bf16_t* __restrict__ YB,
                                                  const int* __restrict__ td, const float* __restrict__ tg, const float* __restrict__ g2, const float* __restrict__ b2, float* __restrict__ out) {
    const int tok = blockIdx.x, tid = threadIdx.x, wave = tid >> 6, lane = tid & 63;
    __shared__ float red[8];
    const f32x4 z = *(const f32x4*)(Z + (size_t)tok * DM + 4 * tid);
    const float mean1 = STAT[2 * tok], rstd1 = STAT[2 * tok + 1];
    const f32x4 h1 = (z - mean1) * rstd1 * *(const f32x4*)(g1 + 4 * tid) + *(const f32x4*)(b1 + 4 * tid);
    f32x4 f = (f32x4){0.f, 0.f, 0.f, 0.f};
#pragma unroll
    for (int k = 0; k < 4; ++k) {
        const bf16_t* yr = YB + (size_t)td[tok * 4 + k] * DM + 4 * tid; const float w = tg[tok * 4 + k];
        f[0] += w * bf2f(yr[0]); f[1] += w * bf2f(yr[1]); f[2] += w * bf2f(yr[2]); f[3] += w * bf2f(yr[3]);
    }
    const f32x4 v = ALPHA * h1 + f;
    float s = wave_sum((v[0] + v[1]) + (v[2] + v[3]));
    if (lane == 0) red[wave] = s;
    __syncthreads();
    const float mean = (red[0] + red[1] + red[2] + red[3]) * (1.0f / DM);
    const f32x4 d = v - mean;
    float q = wave_sum((d[0] * d[0] + d[1] * d[1]) + (d[2] * d[2] + d[3] * d[3]));
    if (lane == 0) red[4 + wave] = q;
    __syncthreads();
    const float rstd = rsqrtf((red[4] + red[5] + red[6] + red[7]) * (1.0f / DM) + LN_EPS);
    *(f32x4*)(out + (size_t)tok * DM + 4 * tid) = d * rstd * *(const f32x4*)(g2 + 4 * tid) + *(const f32x4*)(b2 + 4 * tid);
}

#define LAS __attribute__((address_space(3)))
typedef unsigned u32x4 __attribute__((ext_vector_type(4)));
typedef float f32x2 __attribute__((ext_vector_type(2)));
typedef float f32x16 __attribute__((ext_vector_type(16)));
constexpr int NWAVES = 8;
constexpr int RING_BYTES = 131072;
constexpr int LDSX_OFF = RING_BYTES;
constexpr int LDS_BYTES = 147456;

__device__ __forceinline__ unsigned cvt_pk_bf16(float lo, float hi) { unsigned r; asm volatile("v_cvt_pk_bf16_f32 %0, %1, %2" : "=v"(r) : "v"(lo), "v"(hi)); return r; }
__device__ __forceinline__ float fast_sigmoid(float x) { return __builtin_amdgcn_rcpf(1.0f + __expf(-x)); }
__device__ __forceinline__ float bflo(unsigned w) { return __uint_as_float(w << 16); }
__device__ __forceinline__ float bfhi(unsigned w) { return __uint_as_float(w & 0xffff0000u); }

#define XB_TMO      128
#define XB_XCNT(j)  (256  + 64 * (j))
#define XB_XSUB(j)  (1280 + 64 * (j))
#define XB_XGEN(j)  (2304 + 64 * (j))
#define XB_TOP      3328
#define XB_TOPGEN   3392
#define XCD_BAR_WORDS 3456
#define XB_SPIN_CAP (1u << 18)
__device__ __forceinline__ unsigned xb_ld(unsigned* p)              { return __hip_atomic_load(p, __ATOMIC_RELAXED, __HIP_MEMORY_SCOPE_AGENT); }
__device__ __forceinline__ unsigned xb_add(unsigned* p, unsigned v) { return __hip_atomic_fetch_add(p, v, __ATOMIC_RELAXED, __HIP_MEMORY_SCOPE_AGENT); }
__device__ __forceinline__ unsigned xb_xcc_id() { return (unsigned)__builtin_amdgcn_s_getreg((3 << 11) | 20) & 0xFu; }
#define XB_SPIN(cond, bar) do { unsigned _sp = 0; while (cond) { __builtin_amdgcn_s_sleep(1); \
    if ((++_sp & 255u) == 0u) { if (xb_ld(&(bar)[XB_TMO])) break; if (_sp > XB_SPIN_CAP) { atomicAdd(&(bar)[XB_TMO], 1u); break; } } } } while (0)
struct XcdBarrier { unsigned* bar; unsigned x; volatile LAS unsigned* st; };
__device__ __forceinline__ XcdBarrier xcd_barrier_post(unsigned* bar, volatile LAS unsigned* st) {
    XcdBarrier b; b.bar = bar; b.x = xb_xcc_id(); b.st = st;
    if (threadIdx.x == 0) (void)xb_add(&bar[XB_XCNT(b.x)], 1u);
    return b;
}
__device__ __forceinline__ void xcd_barrier_complete(unsigned* bar, unsigned x, unsigned& nloc, unsigned& nx) {
    const unsigned G = gridDim.x * gridDim.y * gridDim.z;
    unsigned sum, cnt, mine, sp = 0u;
    for (;;) {
        sum = 0u; cnt = 0u; mine = 0u;
#pragma unroll
        for (unsigned j = 0; j < 16; ++j) { const unsigned c = xb_ld(&bar[XB_XCNT(j)]); sum += c; cnt += (c > 0u) ? 1u : 0u; mine = (j == x) ? c : mine; }
        if (sum == G) break;
        __builtin_amdgcn_s_sleep(1);
        if ((++sp & 255u) == 0u) { if (xb_ld(&bar[XB_TMO])) break; if (sp > XB_SPIN_CAP) { atomicAdd(&bar[XB_TMO], 1u); break; } }
    }
    nloc = mine > 0u ? mine : 1u; nx = cnt > 0u ? cnt : 1u;
}
__device__ __forceinline__ void xcd_barrier(const XcdBarrier& b) {
    asm volatile("s_waitcnt vmcnt(0)" ::: "memory");
    __syncthreads();
    if (threadIdx.x == 0) {
        unsigned* bar = b.bar;
        __builtin_amdgcn_s_waitcnt(0);
        unsigned nloc = b.st[0], nx = b.st[1];
        if (nloc == 0u) { xcd_barrier_complete(bar, b.x, nloc, nx); b.st[0] = nloc; b.st[1] = nx; }
        const unsigned old = xb_add(&bar[XB_XSUB(b.x)], 1u);
        const unsigned gen = old / nloc;
        if (old + 1u == (gen + 1u) * nloc) {
            __builtin_amdgcn_fence(__ATOMIC_RELEASE, "agent");
            asm volatile("s_waitcnt vmcnt(0)" ::: "memory");
            const unsigned og = xb_add(&bar[XB_TOP], 1u);
            const unsigned tg = og / nx;
            if (og + 1u == (tg + 1u) * nx) xb_add(&bar[XB_TOPGEN], 1u);
            else XB_SPIN(xb_ld(&bar[XB_TOPGEN]) == tg, bar);
            __builtin_amdgcn_fence(__ATOMIC_ACQUIRE, "agent");
            xb_add(&bar[XB_XGEN(b.x)], 1u);
            asm volatile("s_waitcnt vmcnt(0)" ::: "memory");
        } else {
            XB_SPIN(xb_ld(&bar[XB_XGEN(b.x)]) == gen, bar);
            __builtin_amdgcn_fence(__ATOMIC_ACQUIRE, "agent");
            asm volatile("s_waitcnt vmcnt(0)" ::: "memory");
        }
    }
    __syncthreads();
}

namespace pg8 {
constexpr int BM = 256, BK = 64, HALF = 128, HTB = HALF * BK * 2, STAGE_BYTES = 8 * HTB, NXCD = 8;
__host__ __device__ __forceinline__ int lds_byte(int r, int c) { const int st = (r >> 4) * 2 + (c >> 5), rr = r & 15, cc = c & 31, ob = rr * 64 + cc * 2; return st * 1024 + (ob ^ (((ob >> 9) & 1) << 5)); }
__host__ __device__ __forceinline__ void stage_rc(int b, int& R, int& C) { const int st = b / 1024, sb = b % 1024, swz = sb ^ (((sb >> 9) & 1) << 5); R = (st >> 1) * 16 + swz / 64; C = (st & 1) * 32 + (swz % 64) / 2; }
__host__ __device__ __forceinline__ int perm32(int rho) { const int n = rho >> 4, i = rho & 15; return 8 * (i >> 2) + 4 * n + (i & 3); }

struct Unit { int pm, pn, e; };
struct Gemm { const bf16_t* A; const bf16_t* Bt; int K, lda, ldb; size_t bstrideE; };

struct StaticOrder {
    int nM, nN, nwg, G, c, wgm;
    __device__ void init(int M, int N, int G_, int c_, int wgm_) { nM = M / BM; nN = N / BM; nwg = nM * nN; G = G_; c = c_; wgm = wgm_; }
    __device__ bool next(int i, Unit& u) const {
        const long L = (long)i * G + c; if (L >= nwg) return false;
        int wgid = (int)L; { const int q = nwg / NXCD, r = nwg % NXCD, xcd = wgid % NXCD, off = wgid / NXCD; wgid = (xcd < r ? xcd * (q + 1) : r * (q + 1) + (xcd - r) * q) + off; }
        const int nig = wgm * nN, gid = wgid / nig, fm = gid * wgm, gsz = (nM - fm) < wgm ? (nM - fm) : wgm;
        u.pm = fm + ((wgid % nig) % gsz); u.pn = (wgid % nig) / gsz; u.e = 0; return true;
    }
};
struct MoeOrder {
    int nT, nN, nwg, G, c; const LAS int* tile_e;
    __device__ bool next(int i, Unit& u) const {
        const long L = (long)i * G + c; if (L >= nwg) return false;
        int wgid = (int)L; { const int q = nwg / NXCD, r = nwg % NXCD, xcd = wgid % NXCD, off = wgid / NXCD; wgid = (xcd < r ? xcd * (q + 1) : r * (q + 1) + (xcd - r) * q) + off; }
        const int nig = 4 * nN, gid = wgid / nig, fm = gid * 4, gsz = (nT - fm) < 4 ? (nT - fm) : 4;
        u.pm = fm + ((wgid % nig) % gsz); u.pn = (wgid % nig) / gsz; u.e = tile_e[u.pm]; return true;
    }
};

typedef f32x4 Acc[2][2][4][2];

template <class Epi, class Sched, bool ALIGN_EPI>
__device__ __forceinline__ void gemm_phase(LAS unsigned char* lds, const Gemm g, const Sched& S, const Epi& E) {
    const int tid = threadIdx.x, wid = __builtin_amdgcn_readfirstlane(tid >> 6), lane = tid & 63, wr = wid >> 2, wc = wid & 3, fr = lane & 15, fq = lane >> 4;
    const int nt = g.K / BK;
    unsigned voffA[2], voffB[2];
#pragma unroll
    for (int i = 0; i < 2; ++i) { int R, C; stage_rc(tid * 16 + i * 8192, R, C); const int Rb = Epi::PERM ? ((R & ~31) + perm32(R & 31)) : R;
        voffA[i] = (unsigned)(R * g.lda + C) * 2u; voffB[i] = (unsigned)(Rb * g.ldb + C) * 2u; }
    const size_t kstep = (size_t)(BK * 2);
    const size_t hstepA = (size_t)HALF * g.lda * 2, hstepB = (size_t)HALF * g.ldb * 2;
    const size_t tstepA = 2 * hstepA, tstepB = 2 * hstepB;
    const unsigned ldsw = (unsigned)wid * 1024u;
    const int aoff = lds_byte(wr * 64 + fr, fq * 8), boff = lds_byte(wc * 32 + fr, fq * 8);
#define PG8_SA(b, h) (((b) * 2 + (h)) * HTB)
#define PG8_SB(b, h) ((4 + (b) * 2 + (h)) * HTB)
#define PG8_STAGE(bufoff, gbase, voff) do { _Pragma("unroll") for (int _i = 0; _i < 2; ++_i) \
        __builtin_amdgcn_global_load_lds((const unsigned*)((const char*)(gbase) + (voff)[_i]), (LAS unsigned*)(lds + (bufoff) + ldsw + _i * 8192), 16, 0, 0); } while (0)
#define PG8_LDA(dst, b, h) do { _Pragma("unroll") for (int m = 0; m < 4; ++m) _Pragma("unroll") for (int k = 0; k < 2; ++k) dst[m][k] = *(const LAS bf16x8*)(lds + PG8_SA(b, h) + aoff + m * 2048 + k * 1024); } while (0)
#define PG8_LDB(dst, b, h) do { _Pragma("unroll") for (int n = 0; n < 2; ++n) _Pragma("unroll") for (int k = 0; k < 2; ++k) dst[n][k] = *(const LAS bf16x8*)(lds + PG8_SB(b, h) + boff + n * 2048 + k * 1024); } while (0)
#define PG8_MMA(ai, bj, At, Bt) do { __builtin_amdgcn_s_setprio(1); _Pragma("unroll") for (int m = 0; m < 4; ++m) _Pragma("unroll") for (int n = 0; n < 2; ++n) _Pragma("unroll") for (int k = 0; k < 2; ++k) \
        acc[ai][bj][m][n] = __builtin_amdgcn_mfma_f32_16x16x32_bf16(Bt[n][k], At[m][k], acc[ai][bj][m][n], 0, 0, 0); __builtin_amdgcn_s_setprio(0); } while (0)
#define PG8_WAIT_V(n) asm volatile("s_waitcnt vmcnt(" #n ")" ::: "memory")
#define PG8_WAIT_L(n) asm volatile("s_waitcnt lgkmcnt(" #n ")" ::: "memory")
#define PG8_BAR __builtin_amdgcn_s_barrier()
#define PG8_SCHED __builtin_amdgcn_sched_barrier(0)
    Unit cur, nxt; int ui = 0;
    if (!S.next(0, cur)) return;
    Acc acc;
#pragma unroll
    for (int a = 0; a < 2; ++a)
#pragma unroll
        for (int b = 0; b < 2; ++b)
#pragma unroll
            for (int m = 0; m < 4; ++m)
#pragma unroll
                for (int n = 0; n < 2; ++n) acc[a][b][m][n] = (f32x4){0.f, 0.f, 0.f, 0.f};
    bf16x8 At[4][2], B0[2][2], B1[2][2];
    const char* cA = (const char*)g.A + (size_t)cur.pm * tstepA; const char* cB = (const char*)g.Bt + (size_t)cur.e * g.bstrideE + (size_t)cur.pn * tstepB;
    PG8_STAGE(PG8_SB(0, 0), cB, voffB); PG8_STAGE(PG8_SB(0, 1), cB + hstepB, voffB); PG8_STAGE(PG8_SA(0, 0), cA, voffA); PG8_STAGE(PG8_SA(0, 1), cA + hstepA, voffA);
    if (wr == 1) PG8_BAR;
    PG8_WAIT_V(2); PG8_BAR;
    PG8_STAGE(PG8_SB(1, 0), cB + kstep, voffB); PG8_STAGE(PG8_SA(1, 0), cA + kstep, voffA); PG8_STAGE(PG8_SB(1, 1), cB + hstepB + kstep, voffB);
    PG8_WAIT_V(6); PG8_BAR;
    for (;;) {
        const bool has_next = S.next(ui + 1, nxt);
        const char* nA = has_next ? (const char*)g.A + (size_t)nxt.pm * tstepA : cA;
        const char* nB = has_next ? (const char*)g.Bt + (size_t)nxt.e * g.bstrideE + (size_t)nxt.pn * tstepB : cB;
        for (int t = 0; t < nt; t += 2) {
            const bool last = (t == nt - 2);
            const char* a1 = cA + (size_t)(t + 1) * kstep;
            const char* a2 = last ? nA : cA + (size_t)(t + 2) * kstep; const char* b2 = last ? nB : cB + (size_t)(t + 2) * kstep;
            const char* a3 = a2 + kstep; const char* b3 = b2 + kstep;
            PG8_LDB(B0, 0, 0); PG8_LDB(B1, 0, 1); PG8_SCHED; PG8_LDA(At, 0, 0); PG8_STAGE(PG8_SA(1, 1), a1 + hstepA, voffA);
            PG8_WAIT_V(8); PG8_WAIT_L(0); PG8_BAR; PG8_MMA(0, 0, At, B0); PG8_MMA(0, 1, At, B1); PG8_BAR; PG8_SCHED;
            PG8_LDA(At, 0, 1); PG8_STAGE(PG8_SB(0, 0), b2, voffB); PG8_STAGE(PG8_SB(0, 1), b2 + hstepB, voffB); PG8_STAGE(PG8_SA(0, 0), a2, voffA);
            PG8_WAIT_V(8); PG8_WAIT_L(0); PG8_BAR; PG8_MMA(1, 0, At, B0); PG8_MMA(1, 1, At, B1); PG8_BAR; PG8_SCHED;
            PG8_LDB(B0, 1, 0); PG8_LDB(B1, 1, 1); PG8_SCHED; PG8_LDA(At, 1, 0); PG8_STAGE(PG8_SA(0, 1), a2 + hstepA, voffA);
            PG8_WAIT_V(8); PG8_WAIT_L(0); PG8_BAR; PG8_MMA(0, 0, At, B0); PG8_MMA(0, 1, At, B1); PG8_BAR; PG8_SCHED;
            PG8_LDA(At, 1, 1); PG8_STAGE(PG8_SB(1, 0), b3, voffB); PG8_STAGE(PG8_SB(1, 1), b3 + hstepB, voffB); PG8_STAGE(PG8_SA(1, 0), a3, voffA);
            PG8_WAIT_V(8); PG8_WAIT_L(0); PG8_BAR; PG8_MMA(1, 0, At, B0); PG8_MMA(1, 1, At, B1); PG8_BAR; PG8_SCHED;
        }
        if constexpr (ALIGN_EPI) { if (wr == 0) PG8_BAR; }
        E(acc, cur, wr, wc, fr, fq);
        if (!has_next) break;
#pragma unroll
        for (int a = 0; a < 2; ++a)
#pragma unroll
            for (int b = 0; b < 2; ++b)
#pragma unroll
                for (int m = 0; m < 4; ++m)
#pragma unroll
                    for (int n = 0; n < 2; ++n) acc[a][b][m][n] = (f32x4){0.f, 0.f, 0.f, 0.f};
        cur = nxt; cA = nA; cB = nB; ++ui;
        if constexpr (ALIGN_EPI) { if (wr == 1) PG8_BAR; }
    }
    PG8_WAIT_V(0);
    if constexpr (!ALIGN_EPI) { if (wr == 0) PG8_BAR; }
    PG8_BAR;
#undef PG8_SA
#undef PG8_SB
#undef PG8_STAGE
#undef PG8_LDA
#undef PG8_LDB
#undef PG8_MMA
#undef PG8_WAIT_V
#undef PG8_WAIT_L
#undef PG8_BAR
#undef PG8_SCHED
}

__device__ __forceinline__ u32x4 pack8(const f32x4 v0, const f32x4 v1) { u32x4 w; w.x = cvt_pk_bf16(v0[0], v0[1]); w.y = cvt_pk_bf16(v0[2], v0[3]); w.z = cvt_pk_bf16(v1[0], v1[1]); w.w = cvt_pk_bf16(v1[2], v1[3]); return w; }
__device__ __forceinline__ void unpack8(const u32x4 w, f32x4& v0, f32x4& v1) { v0 = (f32x4){bflo(w.x), bfhi(w.x), bflo(w.y), bfhi(w.y)}; v1 = (f32x4){bflo(w.z), bfhi(w.z), bflo(w.w), bfhi(w.w)}; }

struct EpiU { static constexpr bool PERM = true; bf16_t* U;
    __device__ __forceinline__ void operator()(const Acc& acc, const Unit& u, int wr, int wc, int fr, int fq) const {
        const int row0 = u.pm * BM + wr * 64 + fr, col0 = u.pn * BM + wc * 32 + 8 * fq;
        const int mode = u.pn < 2 ? 1 : (u.pn >= 5 ? 2 : 0);
#pragma unroll
        for (int ai = 0; ai < 2; ++ai)
#pragma unroll
            for (int m = 0; m < 4; ++m) { bf16_t* rowp = U + (size_t)(row0 + ai * HALF + m * 16) * INW + col0;
#pragma unroll
                for (int bj = 0; bj < 2; ++bj) { f32x4 v0 = acc[ai][bj][m][0], v1 = acc[ai][bj][m][1];
                    if (mode == 1) { v0 = v0 * 0.125f; v1 = v1 * 0.125f; }
                    else if (mode == 2) {
#pragma unroll
                        for (int j = 0; j < 4; ++j) { v0[j] = fast_sigmoid(v0[j]); v1[j] = fast_sigmoid(v1[j]); } }
                    *(u32x4*)(rowp + bj * HALF) = pack8(v0, v1); } }
    } };
struct EpiBrA { static constexpr bool PERM = true; const bf16_t* U; float* T;
    __device__ __forceinline__ void operator()(const Acc& acc, const Unit& u, int wr, int wc, int fr, int fq) const {
        const int row0 = u.pm * BM + wr * 64 + fr, col0 = u.pn * BM + wc * 32 + 8 * fq;
#pragma unroll
        for (int ai = 0; ai < 2; ++ai)
#pragma unroll
            for (int m = 0; m < 4; ++m) { const size_t row = (size_t)(row0 + ai * HALF + m * 16);
#pragma unroll
                for (int bj = 0; bj < 2; ++bj) { const int col = col0 + bj * HALF; f32x4 g0, g1; unpack8(*(const u32x4*)(U + row * INW + OGA + col), g0, g1);
                    float* tp = T + row * DM + col; *(f32x4*)tp = g0 * acc[ai][bj][m][0]; *(f32x4*)(tp + 4) = g1 * acc[ai][bj][m][1]; } }
    } };
struct EpiBrP { static constexpr bool PERM = true; const bf16_t* U; const float* T; bf16_t* MIX;
    __device__ __forceinline__ void operator()(const Acc& acc, const Unit& u, int wr, int wc, int fr, int fq) const {
        const int row0 = u.pm * BM + wr * 64 + fr, col0 = u.pn * BM + wc * 32 + 8 * fq;
#pragma unroll
        for (int ai = 0; ai < 2; ++ai)
#pragma unroll
            for (int m = 0; m < 4; ++m) { const size_t row = (size_t)(row0 + ai * HALF + m * 16);
#pragma unroll
                for (int bj = 0; bj < 2; ++bj) { const int col = col0 + bj * HALF; f32x4 g0, g1; unpack8(*(const u32x4*)(U + row * INW + OGP + col), g0, g1);
                    const float* tp = T + row * DM + col; const f32x4 t0 = *(const f32x4*)tp, t1 = *(const f32x4*)(tp + 4);
                    *(u32x4*)(MIX + row * DM + col) = pack8(t0 + g0 * acc[ai][bj][m][0], t1 + g1 * acc[ai][bj][m][1]); } }
    } };
struct EpiZ { static constexpr bool PERM = false; const float* x; float* Z;
    __device__ __forceinline__ void operator()(const Acc& acc, const Unit& u, int wr, int wc, int fr, int fq) const {
        const int row0 = u.pm * BM + wr * 64 + fr, col0 = u.pn * BM + wc * 32 + 4 * fq;
#pragma unroll
        for (int ai = 0; ai < 2; ++ai)
#pragma unroll
            for (int m = 0; m < 4; ++m) { const size_t off = (size_t)(row0 + ai * HALF + m * 16) * DM + col0;
#pragma unroll
                for (int bj = 0; bj < 2; ++bj)
#pragma unroll
                    for (int n = 0; n < 2; ++n) { const f32x4 xv = *(const f32x4*)(x + off + bj * HALF + n * 16); *(f32x4*)(Z + off + bj * HALF + n * 16) = xv * ALPHA + acc[ai][bj][m][n]; } }
    } };
struct EpiAct { static constexpr bool PERM = true; const float* b1; bf16_t* ACT;
    __device__ __forceinline__ void operator()(const Acc& acc, const Unit& u, int wr, int wc, int fr, int fq) const {
        const int row0 = u.pm * BM + wr * 64 + fr, j0 = u.pn * HALF + wc * 32 + 8 * fq;
        const float* bp = b1 + (size_t)u.e * 2 * DE + j0;
        const f32x4 bg0 = *(const f32x4*)bp, bg1 = *(const f32x4*)(bp + 4), bu0 = *(const f32x4*)(bp + DE), bu1 = *(const f32x4*)(bp + DE + 4);
#pragma unroll
        for (int ai = 0; ai < 2; ++ai)
#pragma unroll
            for (int m = 0; m < 4; ++m) {
                f32x4 o[2];
#pragma unroll
                for (int n = 0; n < 2; ++n) { const f32x4 hg = acc[ai][0][m][n] + (n ? bg1 : bg0), hu = acc[ai][1][m][n] + (n ? bu1 : bu0);
#pragma unroll
                    for (int j = 0; j < 4; ++j) { const float gate = fminf(hg[j], 7.0f), up = fminf(fmaxf(hu[j], -7.0f), 7.0f); o[n][j] = (up + 1.0f) * gate * fast_sigmoid(1.702f * gate); } }
                *(u32x4*)(ACT + (size_t)(row0 + ai * HALF + m * 16) * DE + j0) = pack8(o[0], o[1]); }
    } };
struct EpiY { static constexpr bool PERM = true; const float* b2; bf16_t* YB;
    __device__ __forceinline__ void operator()(const Acc& acc, const Unit& u, int wr, int wc, int fr, int fq) const {
        const int row0 = u.pm * BM + wr * 64 + fr, col0 = u.pn * BM + wc * 32 + 8 * fq;
        const float* bp = b2 + (size_t)u.e * DM + col0;
        f32x4 bv[2][2];
#pragma unroll
        for (int bj = 0; bj < 2; ++bj) { bv[bj][0] = *(const f32x4*)(bp + bj * HALF); bv[bj][1] = *(const f32x4*)(bp + bj * HALF + 4); }
#pragma unroll
        for (int ai = 0; ai < 2; ++ai)
#pragma unroll
            for (int m = 0; m < 4; ++m) { bf16_t* rowp = YB + (size_t)(row0 + ai * HALF + m * 16) * DM + col0;
#pragma unroll
                for (int bj = 0; bj < 2; ++bj) *(u32x4*)(rowp + bj * HALF) = pack8(acc[ai][bj][m][0] + bv[bj][0], acc[ai][bj][m][1] + bv[bj][1]); }
    } };
}

__device__ __forceinline__ void p0_item(const float* W, int N, int k0, int n0, bf16_t* WT, int ldt, int drow0, int dk0, LAS float* scr, int lane) {
#pragma unroll 8
    for (int i = 0; i < 32; ++i) { const int kk = 2 * i + (lane >> 5); scr[kk * 33 + (lane & 31)] = W[(size_t)(k0 + kk) * N + n0 + (lane & 31)]; }
    asm volatile("s_waitcnt lgkmcnt(0)" ::: "memory");
    const int c = lane & 7;
#pragma unroll
    for (int j = 0; j < 4; ++j) { const int n = (lane >> 3) + 8 * j; const LAS float* s = scr + (8 * c) * 33 + n;
        u32x4 o; o.x = cvt_pk_bf16(s[0 * 33], s[1 * 33]); o.y = cvt_pk_bf16(s[2 * 33], s[3 * 33]); o.z = cvt_pk_bf16(s[4 * 33], s[5 * 33]); o.w = cvt_pk_bf16(s[6 * 33], s[7 * 33]);
        *(u32x4*)(WT + (size_t)(drow0 + n) * ldt + dk0 + k0 + 8 * c) = o; }
    asm volatile("s_waitcnt lgkmcnt(0)" ::: "memory");
}

struct MArgs { const float* in[18]; float* out; unsigned char* ws; int ph_lo, ph_hi, li, pad; };

__global__ void __launch_bounds__(NWAVES * 64, 2) mega(MArgs a) {
    extern __shared__ __attribute__((aligned(16))) unsigned char lds_raw[];
    LAS unsigned char* lds = (LAS unsigned char*)lds_raw;
    volatile LAS unsigned* XW = (volatile LAS unsigned*)(lds + LDSX_OFF);
    const int tid = threadIdx.x, lane = tid & 63, wave = __builtin_amdgcn_readfirstlane(tid >> 6);
    const int G = gridDim.x, bx = blockIdx.x;
    const int vcu = (G % 8 == 0) ? (bx % 8) * (G / 8) + bx / 8 : bx;
    unsigned char* ws = a.ws;
    unsigned* ctl = (unsigned*)(ws + WS_CTL);
    bf16_t* U = (bf16_t*)(ws + WS_U); bf16_t* AY = (bf16_t*)(ws + WS_AY); bf16_t* MIX = (bf16_t*)(ws + WS_MIX); bf16_t* XB = (bf16_t*)(ws + WS_XB);
    float* Z = (float*)(ws + WS_Z); bf16_t* XS = (bf16_t*)(ws + WS_XS); bf16_t* ACT = (bf16_t*)(ws + WS_ACT); float* T = (float*)(ws + WS_ACT); bf16_t* YB = XS;
    bf16_t* Wint = (bf16_t*)(ws + WS_WIN); bf16_t* Wab = (bf16_t*)(ws + WS_WAB); bf16_t* Wot = (bf16_t*)(ws + WS_WO); bf16_t* W1t = (bf16_t*)(ws + WS_W1); bf16_t* W2t = (bf16_t*)(ws + WS_W2);
    float* WgT = (float*)(ws + WS_WR); bf16_t* H1B = (bf16_t*)(ws + WS_H1B); float* STAT = (float*)(ws + WS_STAT);
    int* te = (int*)(ws + WS_TE); float* tg = (float*)(ws + WS_TG); int* tr = (int*)(ws + WS_TR); int* td = (int*)(ws + WS_TD);
    if (tid < 16) XW[tid] = 0u;
    __syncthreads();
    XcdBarrier bar = xcd_barrier_post(ctl + CW_BAR + a.li * XCD_BAR_WORDS, XW);
    const int lo = a.ph_lo, hi = a.ph_hi;
#define IN(k) (lo <= (k) && (k) < hi)
#define SEAM(k) do { if (IN(k) && IN((k) + 1)) xcd_barrier(bar); } while (0)

    if (IN(0)) {
        LAS float* scr = (LAS float*)(lds + wave * 16384);
        const int gw = vcu * NWAVES + wave, NGW = G * NWAVES;
        constexpr int I_IN = (DM / 64) * (INW / 32), I_AB = (512 / 64) * (DM / 32), I_O = (DM / 64) * (DM / 32), I_1 = (DM / 64) * (2 * DE / 32), I_2 = (DE / 64) * (DM / 32);
        constexpr int NITEMS = I_IN + 2 * I_AB + I_O + NE * (I_1 + I_2);
        for (int it = gw; it < NITEMS; it += NGW) {
            int r = it;
            if (r < I_IN) { const int nb = INW / 32; p0_item(a.in[1], INW, 64 * (r / nb), 32 * (r % nb), Wint, DM, 32 * (r % nb), 0, scr, lane); continue; } r -= I_IN;
            if (r < I_AB) { const int nb = DM / 32; p0_item(a.in[3], DM, 64 * (r / nb), 32 * (r % nb), Wab, DM, 32 * (r % nb), 0, scr, lane); continue; } r -= I_AB;
            if (r < I_AB) { const int nb = DM / 32; p0_item(a.in[6], DM, 64 * (r / nb), 32 * (r % nb), Wab, DM, 32 * (r % nb), 512, scr, lane); continue; } r -= I_AB;
            if (r < I_O) { const int nb = DM / 32; p0_item(a.in[7], DM, 64 * (r / nb), 32 * (r % nb), Wot, DM, 32 * (r % nb), 0, scr, lane); continue; } r -= I_O;
            if (r < NE * I_1) { const int e = r / I_1, q = r % I_1, nb = 2 * DE / 32, n0 = 32 * (q % nb);
                const int drow = n0 < DE ? 256 * (n0 >> 7) + (n0 & 127) : 256 * ((n0 - DE) >> 7) + 128 + ((n0 - DE) & 127);
                p0_item(a.in[12] + (size_t)e * DM * 2 * DE, 2 * DE, 64 * (q / nb), n0, W1t + (size_t)e * 2 * DE * DM, DM, drow, 0, scr, lane); continue; } r -= NE * I_1;
            { const int e = r / I_2, q = r % I_2, nb = DM / 32; p0_item(a.in[14] + (size_t)e * DE * DM, DM, 64 * (q / nb), 32 * (q % nb), W2t + (size_t)e * DM * DE, DE, 32 * (q % nb), 0, scr, lane); }
        }
        {
            const float* g1 = a.in[8]; const float* b1 = a.in[9]; const float* wr = a.in[10]; const float* br = a.in[11];
            for (int i = gw * 64 + lane; i < NE * DM; i += NGW * 64) { const int e = i >> 10, c = i & 1023; WgT[i] = g1[c] * wr[c * NE + e]; }
            if (gw < 64) { const int e = gw & 31, which = gw >> 5; float sacc = 0.f;
                for (int c = lane; c < DM; c += 64) sacc += (which ? b1[c] : g1[c]) * wr[c * NE + e];
                sacc = wave_sum(sacc);
                if (lane == 0) { if (which) WgT[NE * DM + 32 + e] = sacc + br[e]; else WgT[NE * DM + e] = sacc; } }
        }
        const float* x = a.in[0];
        for (size_t i = ((size_t)gw * 64 + lane) * 8; i < (size_t)NTOK * DM; i += (size_t)NGW * 64 * 8) {
            const f32x4 v0 = *(const f32x4*)(x + i), v1 = *(const f32x4*)(x + i + 4);
            *(u32x4*)(XB + i) = pg8::pack8(v0, v1); }
    }
    SEAM(0);
    if (IN(1)) {
        pg8::Gemm g{XB, Wint, DM, DM, DM, 0}; pg8::StaticOrder S; S.init(NTOK, INW, G, bx, 8);
        pg8::gemm_phase<pg8::EpiU, pg8::StaticOrder, true>(lds, g, S, pg8::EpiU{U});
    }
    SEAM(1);
    if (IN(2)) {
        const float* sinks = a.in[2]; const float* wg = a.in[4]; const float* pscale = a.in[5];
        LAS float* pbuf = (LAS float*)(lds + wave * 2048); LAS float* qs = pbuf + 320;
        const int tpw = NTOK / G;
        for (int it = 0; it < tpw; ++it) {
            const int tok = vcu * tpw + it, h = wave, b = tok / SEQ, t = tok % SEQ, kvh = h >> 2;
            qs[lane] = bf2f(U[(size_t)tok * INW + OQ + h * 64 + lane]);
            asm volatile("s_waitcnt lgkmcnt(0)" ::: "memory");
            const int klo = max(t - 128, 0), khi = min(t + 128, SEQ - 1), nk = khi - klo + 1;
            const float slope = exp2f(-(float)(h + 1)), sink = sinks[h];
            float sc[5]; float mx = -INFINITY;
#pragma unroll
            for (int i = 0; i < 5; ++i) {
                const int idx = lane + 64 * i; sc[i] = -INFINITY;
                if (idx < nk) {
                    const int sx = klo + idx; const bf16_t* kr = U + (size_t)(b * SEQ + sx) * INW + OKK + kvh * 64; float d = 0.f;
#pragma unroll
                    for (int c8 = 0; c8 < 8; ++c8) { f32x4 k0, k1; pg8::unpack8(*(const u32x4*)(kr + 8 * c8), k0, k1); const f32x4 q0 = *(const LAS f32x4*)(qs + 8 * c8), q1 = *(const LAS f32x4*)(qs + 8 * c8 + 4);
                        d += (q0[0] * k0[0] + q0[1] * k0[1]) + (q0[2] * k0[2] + q0[3] * k0[3]) + (q1[0] * k1[0] + q1[1] * k1[1]) + (q1[2] * k1[2] + q1[3] * k1[3]); }
                    sc[i] = d - slope * fabsf((float)(sx - t)); mx = fmaxf(mx, sc[i]);
                }
            }
            const float m = fmaxf(wave_max(mx), sink);
            float ps = 0.f;
#pragma unroll
            for (int i = 0; i < 5; ++i) { sc[i] = __expf(sc[i] - m); ps += sc[i]; }
            const float inv = 1.0f / (wave_sum(ps) + __expf(sink - m));
#pragma unroll
            for (int i = 0; i < 5; ++i) pbuf[lane + 64 * i] = sc[i] * inv;
            asm volatile("s_waitcnt lgkmcnt(0)" ::: "memory");
            float o = 0.f;
            for (int idx = 0; idx < nk; ++idx) o += pbuf[idx] * bf2f(U[(size_t)(b * SEQ + klo + idx) * INW + OV + kvh * 64 + lane]);
            AY[(size_t)tok * DM + h * 64 + lane] = f2bf(o);
            asm volatile("s_waitcnt lgkmcnt(0)" ::: "memory");
        }
        __syncthreads();
        LAS float* yb = (LAS float*)(lds + 16384) + (tid >> 8) * 512; const int t256 = tid & 255;
        for (int it = 0; it < tpw / 2; ++it) {
            const int tok = vcu * tpw + 2 * it + (tid >> 8), b = tok / SEQ, t = tok % SEQ;
            for (int c = t256; c < 512; c += 256) {
                const int g = c >> 7, w = 2 << g, plo = max(t - w / 2, 0), phi = min(t + w / 2 - 1, SEQ - 1);
                float sacc = 0.f;
                for (int q = plo; q <= phi; ++q) sacc += bf2f(U[(size_t)(b * SEQ + q) * INW + OP + c]);
                yb[c] = sacc / (float)(phi - plo + 1) - bf2f(U[(size_t)tok * INW + OP + c]);
            }
            __syncthreads();
            for (int o = t256; o < 512; o += 256) {
                const int g = o >> 7, d = o & 127; float acc = 0.f;
                for (int c = 0; c < 128; ++c) acc += yb[g * 128 + c] * wg[(size_t)(g * 128 + c) * 128 + d];
                AY[(size_t)tok * DM + 512 + o] = f2bf(acc * pscale[o]);
            }
            __syncthreads();
        }
    }
    SEAM(2);
    if (IN(3)) {
        pg8::StaticOrder S; S.init(NTOK, DM, G, bx, 8);
        { pg8::Gemm g{AY, Wab, 512, DM, DM, 0}; pg8::gemm_phase<pg8::EpiBrA, pg8::StaticOrder, true>(lds, g, S, pg8::EpiBrA{U, T}); }
        asm volatile("s_waitcnt vmcnt(0)" ::: "memory"); __syncthreads();
        { pg8::Gemm g{AY + 512, Wab + 512, 512, DM, DM, 0}; pg8::gemm_phase<pg8::EpiBrP, pg8::StaticOrder, true>(lds, g, S, pg8::EpiBrP{U, T, MIX}); }
    }
    SEAM(3);
    if (IN(4)) {
        pg8::Gemm g{MIX, Wot, DM, DM, DM, 0}; pg8::StaticOrder S; S.init(NTOK, DM, G, bx, 8);
        pg8::gemm_phase<pg8::EpiZ, pg8::StaticOrder, true>(lds, g, S, pg8::EpiZ{a.in[0], Z});
    }
    SEAM(4);
    if (IN(5)) {
        const float* g1 = a.in[8]; const float* b1 = a.in[9];
        LAS float* part = (LAS float*)lds;
        LAS float* stat = (LAS float*)(lds + 40960);
        LAS float* lgs = (LAS float*)(lds + 49152);
        LAS int* lcnt = (LAS int*)(lds + 61440);
        for (int tile = bx; tile < NTOK / 64; tile += G) {
            if (tid < 64) lcnt[tid] = 0;
            for (int i = 0; i < 8; ++i) {
                const int r = 8 * wave + i, tok = tile * 64 + r; f32x4 v[4]; float sacc = 0.f;
#pragma unroll
                for (int j = 0; j < 4; ++j) { v[j] = *(const f32x4*)(Z + (size_t)tok * DM + 256 * j + 4 * lane); sacc += (v[j][0] + v[j][1]) + (v[j][2] + v[j][3]); }
                const float mean = wave_sum(sacc) * (1.0f / DM); float q = 0.f;
#pragma unroll
                for (int j = 0; j < 4; ++j) { v[j] = v[j] - mean; q += (v[j][0] * v[j][0] + v[j][1] * v[j][1]) + (v[j][2] * v[j][2] + v[j][3] * v[j][3]); }
                const float rstd = rsqrtf(wave_sum(q) * (1.0f / DM) + LN_EPS);
#pragma unroll
                for (int j = 0; j < 4; ++j) { const f32x4 hv = v[j] * rstd * *(const f32x4*)(g1 + 256 * j + 4 * lane) + *(const f32x4*)(b1 + 256 * j + 4 * lane);
                    uint2 o; o.x = cvt_pk_bf16(hv[0], hv[1]); o.y = cvt_pk_bf16(hv[2], hv[3]); *(uint2*)(H1B + (size_t)tok * DM + 256 * j + 4 * lane) = o; }
                if (lane == 0) { stat[2 * r] = mean; stat[2 * r + 1] = rstd; STAT[2 * tok] = mean; STAT[2 * tok + 1] = rstd; }
            }
            {
                const int tt = wave >> 2, kq = wave & 3, half = lane >> 5, j32 = lane & 31;
                const float* zr = Z + (size_t)(tile * 64 + 32 * tt + j32) * DM + 256 * kq + 4 * half;
                const float* wrow = WgT + (size_t)j32 * DM + 256 * kq + 4 * half;
                f32x16 acc;
#pragma unroll
                for (int r = 0; r < 16; ++r) acc[r] = 0.f;
#pragma unroll 4
                for (int g = 0; g < 32; ++g) { const f32x4 av = *(const f32x4*)(zr + 8 * g), bv = *(const f32x4*)(wrow + 8 * g);
#pragma unroll
                    for (int ii = 0; ii < 4; ++ii) acc = __builtin_amdgcn_mfma_f32_32x32x2f32(av[ii], bv[ii], acc, 0, 0, 0); }
#pragma unroll
                for (int r = 0; r < 16; ++r) part[((tt * 4 + kq) * 32 + ((r & 3) + 8 * (r >> 2) + 4 * half)) * 33 + j32] = acc[r];
            }
            __syncthreads();
            if (wave == 0) {
                const int t = lane, tok = tile * 64 + t; const float mean = stat[2 * t], rstd = stat[2 * t + 1];
                const LAS float* pp = part + ((t >> 5) * 4 * 32 + (t & 31)) * 33;
                for (int e = 0; e < NE; ++e) { const float sv = (pp[e] + pp[32 * 33 + e]) + (pp[2 * 32 * 33 + e] + pp[3 * 32 * 33 + e]);
                    lgs[t * 33 + e] = rstd * (sv - mean * WgT[NE * DM + e]) + WgT[NE * DM + 32 + e]; }
                float sv[4]; int se[4];
#pragma unroll
                for (int k = 0; k < 4; ++k) { float best = -INFINITY; int bi = 0;
                    for (int e = 0; e < NE; ++e) { const float xv = lgs[t * 33 + e]; if (xv > best) { best = xv; bi = e; } }
                    sv[k] = best; se[k] = bi; lgs[t * 33 + bi] = -INFINITY; }
                float ex[4], sum = 0.f; int rl[4];
#pragma unroll
                for (int k = 0; k < 4; ++k) { ex[k] = __expf(sv[k] - sv[0]); sum += ex[k]; rl[k] = atomicAdd((int*)&lcnt[se[k]], 1); }
                asm volatile("s_waitcnt lgkmcnt(0)" ::: "memory");
                if (lane < 32) lcnt[32 + lane] = atomicAdd((int*)&ctl[lane], lcnt[lane]);
                asm volatile("s_waitcnt vmcnt(0) lgkmcnt(0)" ::: "memory");
                const float rs = 1.0f / sum;
#pragma unroll
                for (int k = 0; k < 4; ++k) { te[tok * 4 + k] = se[k]; tg[tok * 4 + k] = ex[k] * rs; tr[tok * 4 + k] = lcnt[32 + se[k]] + rl[k]; }
            }
            __syncthreads();
        }
    }
    SEAM(5);
    if (IN(6)) {
        LAS int* pst = (LAS int*)(lds + LDSX_OFF + 2048);
        if (tid == 0) { int ps = 0; for (int e = 0; e < NE; ++e) { pst[e] = ps; ps += (((int)ctl[e] + 255) >> 8) << 8; } }
        __syncthreads();
        const int gw = vcu * NWAVES + wave, NGW = G * NWAVES;
        for (int as = gw; as < NTOK * TOPK; as += NGW) {
            const int tok = as >> 2, dest = pst[te[as]] + tr[as];
            if (lane == 0) td[as] = dest;
            const u32x4* src = (const u32x4*)(H1B + (size_t)tok * DM); u32x4* dst = (u32x4*)(XS + (size_t)dest * DM);
            dst[lane] = src[lane]; dst[64 + lane] = src[64 + lane];
        }
    }
    SEAM(6);
    if (IN(7) || IN(8)) {
        LAS int* tile_e = (LAS int*)(lds + LDSX_OFF + 256);
        if (tid == 0) { int ps = 0; for (int e = 0; e < NE; ++e) { const int nt = ((int)ctl[e] + 255) >> 8; for (int i = 0; i < nt; ++i) tile_e[1 + ps + i] = e; ps += nt; } tile_e[0] = ps; }
        __syncthreads();
        const int nT = tile_e[0];
        if (IN(7)) {
            pg8::Gemm g{XS, W1t, DM, DM, DM, (size_t)2 * DE * DM * 2}; pg8::MoeOrder S{nT, DE / 128, nT * (DE / 128), G, bx, tile_e + 1};
            pg8::gemm_phase<pg8::EpiAct, pg8::MoeOrder, true>(lds, g, S, pg8::EpiAct{a.in[13], ACT});
        }
        SEAM(7);
        if (IN(8)) {
            pg8::Gemm g{ACT, W2t, DE, DE, DE, (size_t)DM * DE * 2}; pg8::MoeOrder S{nT, DM / 256, nT * (DM / 256), G, bx, tile_e + 1};
            pg8::gemm_phase<pg8::EpiY, pg8::MoeOrder, true>(lds, g, S, pg8::EpiY{a.in[15], YB});
        }
    }
    SEAM(8);
    if (IN(9)) {
        const float* g1 = a.in[8]; const float* b1 = a.in[9]; const float* g2 = a.in[16]; const float* b2 = a.in[17];
        const int gw = vcu * NWAVES + wave, NGW = G * NWAVES;
        for (int tok = gw; tok < NTOK; tok += NGW) {
            const float mean1 = STAT[2 * tok], rstd1 = STAT[2 * tok + 1];
            int dk[4]; float wk[4];
#pragma unroll
            for (int k = 0; k < 4; ++k) { dk[k] = td[tok * 4 + k]; wk[k] = tg[tok * 4 + k]; }
            f32x4 v[4]; float sacc = 0.f;
#pragma unroll
            for (int j = 0; j < 4; ++j) { const int c = 256 * j + 4 * lane;
                const f32x4 z = *(const f32x4*)(Z + (size_t)tok * DM + c);
                f32x4 h1 = (z - mean1) * rstd1 * *(const f32x4*)(g1 + c) + *(const f32x4*)(b1 + c);
                f32x4 f = (f32x4){0.f, 0.f, 0.f, 0.f};
#pragma unroll
                for (int k = 0; k < 4; ++k) { const uint2 y = *(const uint2*)(YB + (size_t)dk[k] * DM + c); f = f + wk[k] * (f32x4){bflo(y.x), bfhi(y.x), bflo(y.y), bfhi(y.y)}; }
                v[j] = ALPHA * h1 + f; sacc += (v[j][0] + v[j][1]) + (v[j][2] + v[j][3]); }
            const float mean = wave_sum(sacc) * (1.0f / DM); float q = 0.f;
#pragma unroll
            for (int j = 0; j < 4; ++j) { v[j] = v[j] - mean; q += (v[j][0] * v[j][0] + v[j][1] * v[j][1]) + (v[j][2] * v[j][2] + v[j][3] * v[j][3]); }
            const float rstd = rsqrtf(wave_sum(q) * (1.0f / DM) + LN_EPS);
#pragma unroll
            for (int j = 0; j < 4; ++j) { const int c = 256 * j + 4 * lane; *(f32x4*)(a.out + (size_t)tok * DM + c) = v[j] * rstd * *(const f32x4*)(g2 + c) + *(const f32x4*)(b2 + c); }
        }
    }
#undef IN
#undef SEAM
}

extern "C" void kernel_launch(void* const* d_in, const int* in_sizes, int n_in, void* d_out, int out_size, void* d_ws, size_t ws_size, hipStream_t stream) {
    static int grid = 0;
    if (grid == 0) {
        if (n_in != 18 || ws_size < WS_END) { fprintf(stderr, "kernel_launch: unexpected n_in %d / ws_size %zu (need %zu)\n", n_in, ws_size, (size_t)WS_END); grid = -1; return; }
        int dev = 0, cus = 0;
        if (hipGetDevice(&dev) != hipSuccess || hipDeviceGetAttribute(&cus, hipDeviceAttributeMultiprocessorCount, dev) != hipSuccess) { grid = -1; return; }
        if (hipFuncSetAttribute((const void*)mega, hipFuncAttributeMaxDynamicSharedMemorySize, LDS_BYTES) != hipSuccess) { fprintf(stderr, "kernel_launch: hipFuncSetAttribute failed\n"); grid = -1; return; }
        grid = cus;
    }
    if (grid < 0) return;
    const float* x = (const float*)d_in[0]; const float* sinks = (const float*)d_in[2];
    const float* w_pg = (const float*)d_in[4]; const float* pscale = (const float*)d_in[5];
    const float* ln1g = (const float*)d_in[8]; const float* ln1b = (const float*)d_in[9]; const float* w_r = (const float*)d_in[10]; const float* b_r = (const float*)d_in[11];
    const float* ln2g = (const float*)d_in[16]; const float* ln2b = (const float*)d_in[17];
    char* ws = (char*)d_ws; float* out = (float*)d_out;
    int* ctl = (int*)(ws + WS_CTL); bf16_t* U = (bf16_t*)(ws + WS_U); bf16_t* AY = (bf16_t*)(ws + WS_AY);
    bf16_t* H1B = (bf16_t*)(ws + WS_H1B); float* Z = (float*)(ws + WS_Z); float* STAT = (float*)(ws + WS_STAT);
    int* te = (int*)(ws + WS_TE); float* tg = (float*)(ws + WS_TG); int* tr = (int*)(ws + WS_TR); int* td = (int*)(ws + WS_TD);
    bf16_t* XS = (bf16_t*)(ws + WS_XS); bf16_t* YB = XS;
    (void)x; (void)in_sizes; (void)out_size;

    if (hipMemsetAsync(ctl, 0, CTL_BYTES, stream) != hipSuccess) return;
    MArgs a{};
    for (int i = 0; i < 18; ++i) a.in[i] = (const float*)d_in[i];
    a.out = out; a.ws = (unsigned char*)d_ws;
    a.ph_lo = 0; a.ph_hi = 10; a.li = 0;
    hipLaunchKernelGGL(mega, dim3(grid), dim3(NWAVES * 64), LDS_BYTES, stream, a);
}
```

```cpp
#include <hip/hip_runtime.h>
#include <stdint.h>
#include <cstdio>

typedef unsigned short bf16_t;
typedef short bf16x8 __attribute__((ext_vector_type(8)));
typedef float f32x4 __attribute__((ext_vector_type(4)));

constexpr int NTOK = 16384, DM = 1024, SEQ = 8192, INW = 3328;
constexpr int OQ = 0, OKK = 512, OV = 640, OP = 768, OGA = 1280, OGP = 2304;
constexpr int NE = 32, TOPK = 4, DE = 1024;
constexpr int MAXROWS = NTOK * TOPK + NE * 256;
constexpr int MAXTILES = MAXROWS / 256;
constexpr float ALPHA = 1.189207115002721f;
constexpr float LN_EPS = 1e-5f;

constexpr size_t WS_CTL = 0, CTL_BYTES = 262144;
constexpr size_t WS_U = CTL_BYTES;
constexpr size_t SZ_U = (size_t)NTOK * INW * 2;
constexpr size_t SZ_A16 = (size_t)NTOK * DM * 2;
constexpr size_t WS_AY = WS_U + SZ_U;
constexpr size_t WS_MIX = WS_AY + SZ_A16;
constexpr size_t WS_H1B = WS_MIX + SZ_A16;
constexpr size_t WS_XB = WS_H1B + SZ_A16;
constexpr size_t WS_Z = WS_XB + SZ_A16;
constexpr size_t WS_STAT = WS_Z + (size_t)NTOK * DM * 4;
constexpr size_t WS_TE = WS_STAT + (size_t)NTOK * 8;
constexpr size_t WS_TG = WS_TE + (size_t)NTOK * 16;
constexpr size_t WS_TR = WS_TG + (size_t)NTOK * 16;
constexpr size_t WS_TD = WS_TR + (size_t)NTOK * 16;
constexpr size_t WS_XS = WS_TD + (size_t)NTOK * 16;
constexpr size_t SZ_XS = (size_t)MAXROWS * DM * 2;
constexpr size_t WS_ACT = WS_XS + SZ_XS;
constexpr size_t WS_WIN = WS_ACT + SZ_XS;
constexpr size_t WS_WAB = WS_WIN + (size_t)INW * DM * 2;
constexpr size_t WS_WO = WS_WAB + (size_t)DM * DM * 2;
constexpr size_t WS_WG = WS_WO + (size_t)DM * DM * 2;
constexpr size_t WS_W1 = WS_WG + (size_t)4 * 128 * 128 * 2;
constexpr size_t WS_W2 = WS_W1 + (size_t)NE * 2 * DE * DM * 2;
constexpr size_t WS_WR = WS_W2 + (size_t)NE * DE * DM * 2;
constexpr size_t WS_END = WS_WR + (size_t)NE * DM * 4 + 256;
constexpr int CW_BAR = 4096;

__device__ __forceinline__ bf16_t f2bf(float f) { uint32_t u = __float_as_uint(f); u += 0x7fffu + ((u >> 16) & 1u); return (bf16_t)(u >> 16); }
__device__ __forceinline__ float bf2f(bf16_t b) { return __uint_as_float(((uint32_t)b) << 16); }
__device__ __forceinline__ float sigmoidf_(float x) { return 1.0f / (1.0f + __expf(-x)); }

__device__ __forceinline__ float wave_sum(float v) {
#pragma unroll
    for (int o = 1; o < 64; o <<= 1) v += __shfl_xor(v, o);
    return v;
}
__device__ __forceinline__ float wave_max(float v) {
#pragma unroll
    for (int o = 1; o < 64; o <<= 1) v = fmaxf(v, __shfl_xor(v, o));
    return v;
}

__global__ __launch_bounds__(256) void k_xconv(const float* __restrict__ x, bf16_t* __restrict__ xb) {
    size_t i = ((size_t)blockIdx.x * 256 + threadIdx.x) * 8;
    f32x4 a = *(const f32x4*)(x + i), b = *(const f32x4*)(x + i + 4);
    bf16x8 o;
    o[0] = f2bf(a[0]); o[1] = f2bf(a[1]); o[2] = f2bf(a[2]); o[3] = f2bf(a[3]);
    o[4] = f2bf(b[0]); o[5] = f2bf(b[1]); o[6] = f2bf(b[2]); o[7] = f2bf(b[3]);
    *(bf16x8*)(xb + i) = o;
}

struct GemmArgs { const bf16_t* A; const float* B; const int* tile_e; const int* ntiles; size_t bstrideE; int lda, ldb, K, dualoff; };

template <class Epi, bool DUAL>
__global__ __launch_bounds__(256) void gemm_v1(GemmArgs g, Epi epi) {
    const int wave = threadIdx.x >> 6, l = threadIdx.x & 63, fr = l & 15, fq = l >> 4;
    const int m0 = blockIdx.y * 64, n0 = blockIdx.x * 64 + wave * 16;
    const float* B = g.B; int e = 0;
    if (g.tile_e) { if ((m0 >> 8) >= *g.ntiles) return; e = g.tile_e[m0 >> 8]; B += (size_t)e * g.bstrideE; }
    f32x4 acc[4], acc2[4];
#pragma unroll
    for (int i = 0; i < 4; ++i) { acc[i] = (f32x4){0.f, 0.f, 0.f, 0.f}; acc2[i] = (f32x4){0.f, 0.f, 0.f, 0.f}; }
    for (int k0 = 0; k0 < g.K; k0 += 32) {
        bf16x8 b, b2;
#pragma unroll
        for (int j = 0; j < 8; ++j) {
            const float* bp = B + (size_t)(k0 + 8 * fq + j) * g.ldb + n0 + fr;
            b[j] = (short)f2bf(bp[0]);
            if (DUAL) b2[j] = (short)f2bf(bp[g.dualoff]);
        }
#pragma unroll
        for (int i = 0; i < 4; ++i) {
            const bf16x8 a = *(const bf16x8*)(g.A + (size_t)(m0 + 16 * i + fr) * g.lda + k0 + 8 * fq);
            acc[i] = __builtin_amdgcn_mfma_f32_16x16x32_bf16(a, b, acc[i], 0, 0, 0);
            if (DUAL) acc2[i] = __builtin_amdgcn_mfma_f32_16x16x32_bf16(a, b2, acc2[i], 0, 0, 0);
        }
    }
#pragma unroll
    for (int i = 0; i < 4; ++i)
#pragma unroll
        for (int r = 0; r < 4; ++r) epi(m0 + 16 * i + 4 * fq + r, n0 + fr, acc[i][r], acc2[i][r], e);
}

struct EpiInproj { bf16_t* U;
    __device__ void operator()(int row, int col, float v, float, int) const {
        float o = v;
        if (col < OKK) o = v * 0.125f; else if (col >= OGA) o = sigmoidf_(v);
        U[(size_t)row * INW + col] = f2bf(o); } };
struct EpiBrA { const bf16_t* U; float* T;
    __device__ void operator()(int row, int col, float v, float, int) const { T[(size_t)row * DM + col] = bf2f(U[(size_t)row * INW + OGA + col]) * v; } };
struct EpiBrP { const bf16_t* U; const float* T; bf16_t* MIX;
    __device__ void operator()(int row, int col, float v, float, int) const { MIX[(size_t)row * DM + col] = f2bf(T[(size_t)row * DM + col] + bf2f(U[(size_t)row * INW + OGP + col]) * v); } };
struct EpiOut { const float* x; float* Z;
    __device__ void operator()(int row, int col, float v, float, int) const { Z[(size_t)row * DM + col] = ALPHA * x[(size_t)row * DM + col] + v; } };
struct EpiMlp1 { const float* b1; bf16_t* ACT;
    __device__ void operator()(int row, int col, float vg, float vu, int e) const {
        vg += b1[(size_t)e * 2 * DE + col]; vu += b1[(size_t)e * 2 * DE + DE + col];
        const float gate = fminf(vg, 7.0f), up = fminf(fmaxf(vu, -7.0f), 7.0f);
        ACT[(size_t)row * DE + col] = f2bf((up + 1.0f) * gate * sigmoidf_(1.702f * gate)); } };
struct EpiMlp2 { const float* b2; bf16_t* YB;
    __device__ void operator()(int row, int col, float v, float, int e) const { YB[(size_t)row * DM + col] = f2bf(v + b2[(size_t)e * DM + col]); } };

__global__ __launch_bounds__(64) void k_attn_v1(const bf16_t* __restrict__ U, const float* __restrict__ sinks, bf16_t* __restrict__ AY) {
    const int tok = blockIdx.x >> 3, h = blockIdx.x & 7, b = tok / SEQ, t = tok % SEQ, kvh = h >> 2, lane = threadIdx.x;
    __shared__ float pbuf[320]; __shared__ float qs[64];
    qs[lane] = bf2f(U[(size_t)tok * INW + OQ + h * 64 + lane]);
    __syncthreads();
    const int lo = max(t - 128, 0), hi = min(t + 128, SEQ - 1), nk = hi - lo + 1;
    const float slope = exp2f(-(float)(h + 1)), sink = sinks[h];
    float sc[5]; float mx = -INFINITY;
#pragma unroll
    for (int i = 0; i < 5; ++i) {
        const int idx = lane + 64 * i; sc[i] = -INFINITY;
        if (idx < nk) {
            const int s = lo + idx; const bf16_t* kr = U + (size_t)(b * SEQ + s) * INW + OKK + kvh * 64; float d = 0.f;
            for (int c = 0; c < 64; ++c) d += qs[c] * bf2f(kr[c]);
            sc[i] = d - slope * fabsf((float)(s - t)); mx = fmaxf(mx, sc[i]);
        }
    }
    const float m = fmaxf(wave_max(mx), sink);
    float ps = 0.f;
#pragma unroll
    for (int i = 0; i < 5; ++i) { sc[i] = __expf(sc[i] - m); ps += sc[i]; }
    const float inv = 1.0f / (wave_sum(ps) + __expf(sink - m));
#pragma unroll
    for (int i = 0; i < 5; ++i) { const int idx = lane + 64 * i; if (idx < 320) pbuf[idx] = sc[i] * inv; }
    __syncthreads();
    float o = 0.f;
    for (int idx = 0; idx < nk; ++idx) o += pbuf[idx] * bf2f(U[(size_t)(b * SEQ + lo + idx) * INW + OV + kvh * 64 + lane]);
    AY[(size_t)tok * DM + h * 64 + lane] = f2bf(o);
}

__global__ __launch_bounds__(256) void k_pool_v1(const bf16_t* __restrict__ U, const float* __restrict__ wg, const float* __restrict__ scale, bf16_t* __restrict__ AY) {
    const int tok = blockIdx.x, b = tok / SEQ, t = tok % SEQ;
    __shared__ float y[512];
    for (int c = threadIdx.x; c < 512; c += 256) {
        const int g = c >> 7, w = 2 << g, lo = max(t - w / 2, 0), hi = min(t + w / 2 - 1, SEQ - 1);
        float s = 0.f;
        for (int q = lo; q <= hi; ++q) s += bf2f(U[(size_t)(b * SEQ + q) * INW + OP + c]);
        y[c] = s / (float)(hi - lo + 1) - bf2f(U[(size_t)tok * INW + OP + c]);
    }
    __syncthreads();
    for (int o = threadIdx.x; o < 512; o += 256) {
        const int g = o >> 7, d = o & 127; float a = 0.f;
        for (int c = 0; c < 128; ++c) a += y[g * 128 + c] * wg[(size_t)(g * 128 + c) * 128 + d];
        AY[(size_t)tok * DM + 512 + o] = f2bf(a * scale[o]);
    }
}

__global__ __launch_bounds__(256) void k_ln_router_v1(const float* __restrict__ Z, const float* __restrict__ g1, const float* __restrict__ b1, const float* __restrict__ wr, const float* __restrict__ br,
                                                      bf16_t* __restrict__ H1B, float* __restrict__ STAT, int* cnt, int* te, float* tg, int* tr) {
    const int tok = blockIdx.x, tid = threadIdx.x, wave = tid >> 6, lane = tid & 63;
    __shared__ float hs[1024]; __shared__ float red[8]; __shared__ float lg[32];
    const f32x4 v = *(const f32x4*)(Z + (size_t)tok * DM + 4 * tid);
    float s = wave_sum((v[0] + v[1]) + (v[2] + v[3]));
    if (lane == 0) red[wave] = s;
    __syncthreads();
    const float mean = (red[0] + red[1] + red[2] + red[3]) * (1.0f / DM);
    const f32x4 d = v - mean;
    float q = wave_sum((d[0] * d[0] + d[1] * d[1]) + (d[2] * d[2] + d[3] * d[3]));
    if (lane == 0) red[4 + wave] = q;
    __syncthreads();
    const float rstd = rsqrtf((red[4] + red[5] + red[6] + red[7]) * (1.0f / DM) + LN_EPS);
    const f32x4 gg = *(const f32x4*)(g1 + 4 * tid), bb = *(const f32x4*)(b1 + 4 * tid);
    const f32x4 hv = d * rstd * gg + bb;
    *(f32x4*)(hs + 4 * tid) = hv;
    bf16_t* hb = H1B + (size_t)tok * DM + 4 * tid;
    hb[0] = f2bf(hv[0]); hb[1] = f2bf(hv[1]); hb[2] = f2bf(hv[2]); hb[3] = f2bf(hv[3]);
    if (tid == 0) { STAT[2 * tok] = mean; STAT[2 * tok + 1] = rstd; }
    __syncthreads();
    for (int e = 8 * wave; e < 8 * wave + 8; ++e) {
        float p = 0.f;
        for (int i = 0; i < 16; ++i) { const int c = lane + 64 * i; p += hs[c] * wr[(size_t)c * NE + e]; }
        p = wave_sum(p);
        if (lane == 0) lg[e] = p + br[e];
    }
    __syncthreads();
    if (tid == 0) {
        float sv[4]; int se[4];
#pragma unroll
        for (int k = 0; k < 4; ++k) {
            float best = -INFINITY; int bi = 0;
            for (int e = 0; e < NE; ++e) { const float x = lg[e]; if (x > best) { best = x; bi = e; } }
            sv[k] = best; se[k] = bi; lg[bi] = -INFINITY;
        }
        float ex[4], sum = 0.f;
#pragma unroll
        for (int k = 0; k < 4; ++k) { ex[k] = __expf(sv[k] - sv[0]); sum += ex[k]; }
#pragma unroll
        for (int k = 0; k < 4; ++k) {
            te[tok * 4 + k] = se[k]; tg[tok * 4 + k] = ex[k] / sum; tr[tok * 4 + k] = atomicAdd(&cnt[se[k]], 1);
        }
    }
}

__global__ void k_book(int* ctl) {
    if (threadIdx.x == 0) {
        int ps = 0;
        for (int e = 0; e < NE; ++e) { ctl[64 + e] = ps; const int nt = (ctl[e] + 255) >> 8; for (int i = 0; i < nt; ++i) ctl[256 + (ps >> 8) + i] = e; ps += nt << 8; }
        ctl[64 + NE] = ps; ctl[128] = ps >> 8;
    }
}

__global__ __launch_bounds__(128) void k_gather_v1(const bf16_t* __restrict__ H1B, const int* __restrict__ ctl, const int* __restrict__ te, const int* __restrict__ tr, int* __restrict__ td, bf16_t* __restrict__ XS) {
    const int a = blockIdx.x, tok = a >> 2;
    const int dest = ctl[64 + te[a]] + tr[a];
    if (threadIdx.x == 0) td[a] = dest;
    *(bf16x8*)(XS + (size_t)dest * DM + 8 * threadIdx.x) = *(const bf16x8*)(H1B + (size_t)tok * DM + 8 * threadIdx.x);
}

__global__ __launch_bounds__(256) void k_final_v1(const float* __restrict__ Z, const float* __restrict__ STAT, const float* __restrict__ g1, const float* __restrict__ b1, const bf16_t* __restrict__ YB,
                                                  const int* __restrict__ td, const float* __restrict__ tg, const float* __restrict__ g2, const float* __restrict__ b2, float* __restrict__ out) {
    const int tok = blockIdx.x, tid = threadIdx.x, wave = tid >> 6, lane = tid & 63;
    __shared__ float red[8];
    const f32x4 z = *(const f32x4*)(Z + (size_t)tok * DM + 4 * tid);
    const float mean1 = STAT[2 * tok], rstd1 = STAT[2 * tok + 1];
    const f32x4 h1 = (z - mean1) * rstd1 * *(const f32x4*)(g1 + 4 * tid) + *(const f32x4*)(b1 + 4 * tid);
    f32x4 f = (f32x4){0.f, 0.f, 0.f, 0.f};
#pragma unroll
    for (int k = 0; k < 4; ++k) {
        const bf16_t* yr = YB + (size_t)td[tok * 4 + k] * DM + 4 * tid; const float w = tg[tok * 4 + k];
        f[0] += w * bf2f(yr[0]); f[1] += w * bf2f(yr[1]); f[2] += w * bf2f(yr[2]); f[3] += w * bf2f(yr[3]);
    }
    const f32x4 v = ALPHA * h1 + f;
    float s = wave_sum((v[0] + v[1]) + (v[2] + v[3]));
    if (lane == 0) red[wave] = s;
    __syncthreads();
    const float mean = (red[0] + red[1] + red[2] + red[3]) * (1.0f / DM);
    const f32x4 d = v - mean;
    float q = wave_sum((d[0] * d[0] + d[1] * d[1]) + (d[2] * d[2] + d[3] * d[3]));
    if (lane == 0) red[4 + wave] = q;
    __syncthreads();
    const float rstd = rsqrtf((red[4] + red[5] + red[6] + red[7]) * (1.0f / DM) + LN_EPS);
    *(f32x4*)(out + (size_t)tok * DM + 4 * tid) = d * rstd * *(const f32x4*)(g2 + 4 * tid) + *(const f32x4*)(b2 + 4 * tid);
}

#define LAS __attribute__((address_space(3)))
typedef unsigned u32x4 __attribute__((ext_vector_type(4)));
typedef float f32x2 __attribute__((ext_vector_type(2)));
typedef unsigned u32x2 __attribute__((ext_vector_type(2)));
typedef float f32x16 __attribute__((ext_vector_type(16)));
constexpr int NWAVES = 8;
constexpr int RING_BYTES = 131072;
constexpr int LDSX_OFF = RING_BYTES;
constexpr int LDS_BYTES = 147456;

typedef __bf16 bf16x2_t __attribute__((ext_vector_type(2)));
__device__ __forceinline__ unsigned cvt_pk_bf16(float lo, float hi) { f32x2 v = {lo, hi}; bf16x2_t b = __builtin_convertvector(v, bf16x2_t); return __builtin_bit_cast(unsigned, b); }
__device__ __forceinline__ float fast_sigmoid(float x) { return __builtin_amdgcn_rcpf(1.0f + __expf(-x)); }
__device__ __forceinline__ float bflo(unsigned w) { return __uint_as_float(w << 16); }
__device__ __forceinline__ float bfhi(unsigned w) { return __uint_as_float(w & 0xffff0000u); }

#define XB_TMO      128
#define XB_XCNT(j)  (256  + 64 * (j))
#define XB_XSUB(j)  (1280 + 64 * (j))
#define XB_XGEN(j)  (2304 + 64 * (j))
#define XB_TOP      3328
#define XB_TOPGEN   3392
#define XCD_BAR_WORDS 3456
#define XB_SPIN_CAP (1u << 18)
__device__ __forceinline__ unsigned xb_ld(unsigned* p)              { return __hip_atomic_load(p, __ATOMIC_RELAXED, __HIP_MEMORY_SCOPE_AGENT); }
__device__ __forceinline__ unsigned xb_add(unsigned* p, unsigned v) { return __hip_atomic_fetch_add(p, v, __ATOMIC_RELAXED, __HIP_MEMORY_SCOPE_AGENT); }
__device__ __forceinline__ unsigned xb_xcc_id() { return (unsigned)__builtin_amdgcn_s_getreg((3 << 11) | 20) & 0xFu; }
#define XB_SPIN(cond, bar) do { unsigned _sp = 0; while (cond) { __builtin_amdgcn_s_sleep(1); \
    if ((++_sp & 255u) == 0u) { if (xb_ld(&(bar)[XB_TMO])) break; if (_sp > XB_SPIN_CAP) { atomicAdd(&(bar)[XB_TMO], 1u); break; } } } } while (0)
struct XcdBarrier { unsigned* bar; unsigned x; volatile LAS unsigned* st; };
__device__ __forceinline__ XcdBarrier xcd_barrier_post(unsigned* bar, volatile LAS unsigned* st) {
    XcdBarrier b; b.bar = bar; b.x = xb_xcc_id(); b.st = st;
    if (threadIdx.x == 0) (void)xb_add(&bar[XB_XCNT(b.x)], 1u);
    return b;
}
__device__ __forceinline__ void xcd_barrier_complete(unsigned* bar, unsigned x, unsigned& nloc, unsigned& nx) {
    const unsigned G = gridDim.x * gridDim.y * gridDim.z;
    unsigned sum, cnt, mine, sp = 0u;
    for (;;) {
        sum = 0u; cnt = 0u; mine = 0u;
#pragma unroll
        for (unsigned j = 0; j < 16; ++j) { const unsigned c = xb_ld(&bar[XB_XCNT(j)]); sum += c; cnt += (c > 0u) ? 1u : 0u; mine = (j == x) ? c : mine; }
        if (sum == G) break;
        __builtin_amdgcn_s_sleep(1);
        if ((++sp & 255u) == 0u) { if (xb_ld(&bar[XB_TMO])) break; if (sp > XB_SPIN_CAP) { atomicAdd(&bar[XB_TMO], 1u); break; } }
    }
    nloc = mine > 0u ? mine : 1u; nx = cnt > 0u ? cnt : 1u;
}
__device__ __forceinline__ void xcd_barrier(const XcdBarrier& b) {
    asm volatile("s_waitcnt vmcnt(0)" ::: "memory");
    __syncthreads();
    if (threadIdx.x == 0) {
        unsigned* bar = b.bar;
        __builtin_amdgcn_s_waitcnt(0);
        unsigned nloc = b.st[0], nx = b.st[1];
        if (nloc == 0u) { xcd_barrier_complete(bar, b.x, nloc, nx); b.st[0] = nloc; b.st[1] = nx; }
        const unsigned old = xb_add(&bar[XB_XSUB(b.x)], 1u);
        const unsigned gen = old / nloc;
        if (old + 1u == (gen + 1u) * nloc) {
            __builtin_amdgcn_fence(__ATOMIC_RELEASE, "agent");
            asm volatile("s_waitcnt vmcnt(0)" ::: "memory");
            const unsigned og = xb_add(&bar[XB_TOP], 1u);
            const unsigned tg = og / nx;
            if (og + 1u == (tg + 1u) * nx) xb_add(&bar[XB_TOPGEN], 1u);
            else XB_SPIN(xb_ld(&bar[XB_TOPGEN]) == tg, bar);
            __builtin_amdgcn_fence(__ATOMIC_ACQUIRE, "agent");
            xb_add(&bar[XB_XGEN(b.x)], 1u);
            asm volatile("s_waitcnt vmcnt(0)" ::: "memory");
        } else {
            XB_SPIN(xb_ld(&bar[XB_XGEN(b.x)]) == gen, bar);
            __builtin_amdgcn_fence(__ATOMIC_ACQUIRE, "agent");
            asm volatile("s_waitcnt vmcnt(0)" ::: "memory");
        }
    }
    __syncthreads();
}

namespace pg8 {
constexpr int BM = 256, BK = 64, HALF = 128, HTB = HALF * BK * 2, STAGE_BYTES = 8 * HTB, NXCD = 8;
__host__ __device__ __forceinline__ int lds_byte(int r, int c) { const int st = (r >> 4) * 2 + (c >> 5), rr = r & 15, cc = c & 31, ob = rr * 64 + cc * 2; return st * 1024 + (ob ^ (((ob >> 9) & 1) << 5)); }
__host__ __device__ __forceinline__ void stage_rc(int b, int& R, int& C) { const int st = b / 1024, sb = b % 1024, swz = sb ^ (((sb >> 9) & 1) << 5); R = (st >> 1) * 16 + swz / 64; C = (st & 1) * 32 + (swz % 64) / 2; }
__host__ __device__ __forceinline__ int perm32(int rho) { const int n = rho >> 4, i = rho & 15; return 8 * (i >> 2) + 4 * n + (i & 3); }

struct Unit { int pm, pn, e; };
struct Gemm { const bf16_t* A; const bf16_t* Bt; int K, lda, ldb; size_t bstrideE; };

struct StaticOrder {
    int nM, nN, nwg, G, c, wgm;
    __device__ void init(int M, int N, int G_, int c_, int wgm_) { nM = M / BM; nN = N / BM; nwg = nM * nN; G = G_; c = c_; wgm = wgm_; }
    __device__ bool next(int i, Unit& u) const {
        const long L = (long)i * G + c; if (L >= nwg) return false;
        int wgid = (int)L; { const int q = nwg / NXCD, r = nwg % NXCD, xcd = wgid % NXCD, off = wgid / NXCD; wgid = (xcd < r ? xcd * (q + 1) : r * (q + 1) + (xcd - r) * q) + off; }
        const int nig = wgm * nN, gid = wgid / nig, fm = gid * wgm, gsz = (nM - fm) < wgm ? (nM - fm) : wgm;
        u.pm = fm + ((wgid % nig) % gsz); u.pn = (wgid % nig) / gsz; u.e = 0; return true;
    }
};
struct MoeOrder {
    int nT, nN, nwg, G, c; const LAS int* tile_e;
    __device__ bool next(int i, Unit& u) const {
        const long L = (long)i * G + c; if (L >= nwg) return false;
        int wgid = (int)L; { const int q = nwg / NXCD, r = nwg % NXCD, xcd = wgid % NXCD, off = wgid / NXCD; wgid = (xcd < r ? xcd * (q + 1) : r * (q + 1) + (xcd - r) * q) + off; }
        const int nig = 4 * nN, gid = wgid / nig, fm = gid * 4, gsz = (nT - fm) < 4 ? (nT - fm) : 4;
        u.pm = fm + ((wgid % nig) % gsz); u.pn = (wgid % nig) / gsz; u.e = tile_e[u.pm]; return true;
    }
};

typedef f32x4 Acc[2][2][4][2];

template <class Epi, class Sched, bool ALIGN_EPI>
__device__ __forceinline__ void gemm_phase(LAS unsigned char* lds, const Gemm g, const Sched& S, const Epi& E) {
    const int tid = threadIdx.x, wid = __builtin_amdgcn_readfirstlane(tid >> 6), lane = tid & 63, wr = wid >> 2, wc = wid & 3, fr = lane & 15, fq = lane >> 4;
    const int nt = g.K / BK;
    unsigned voffA[2], voffB[2];
#pragma unroll
    for (int i = 0; i < 2; ++i) { int R, C; stage_rc(tid * 16 + i * 8192, R, C); const int Rb = Epi::PERM ? ((R & ~31) + perm32(R & 31)) : R;
        voffA[i] = (unsigned)(R * g.lda + C) * 2u; voffB[i] = (unsigned)(Rb * g.ldb + C) * 2u; }
    const size_t kstep = (size_t)(BK * 2);
    const size_t hstepA = (size_t)HALF * g.lda * 2, hstepB = (size_t)HALF * g.ldb * 2;
    const size_t tstepA = 2 * hstepA, tstepB = 2 * hstepB;
    const unsigned ldsw = (unsigned)wid * 1024u;
    const int aoff = lds_byte(wr * 64 + fr, fq * 8), boff = lds_byte(wc * 32 + fr, fq * 8);
#define PG8_SA(b, h) (((b) * 2 + (h)) * HTB)
#define PG8_SB(b, h) ((4 + (b) * 2 + (h)) * HTB)
#define PG8_STAGE(bufoff, gbase, voff) do { _Pragma("unroll") for (int _i = 0; _i < 2; ++_i) \
        __builtin_amdgcn_global_load_lds((const unsigned*)((const char*)(gbase) + (voff)[_i]), (LAS unsigned*)(lds + (bufoff) + ldsw + _i * 8192), 16, 0, 0); } while (0)
#define PG8_LDA(dst, b, h) do { _Pragma("unroll") for (int m = 0; m < 4; ++m) _Pragma("unroll") for (int k = 0; k < 2; ++k) dst[m][k] = *(const LAS bf16x8*)(lds + PG8_SA(b, h) + aoff + m * 2048 + k * 1024); } while (0)
#define PG8_LDB(dst, b, h) do { _Pragma("unroll") for (int n = 0; n < 2; ++n) _Pragma("unroll") for (int k = 0; k < 2; ++k) dst[n][k] = *(const LAS bf16x8*)(lds + PG8_SB(b, h) + boff + n * 2048 + k * 1024); } while (0)
#define PG8_MMA(ai, bj, At, Bt) do { __builtin_amdgcn_s_setprio(1); _Pragma("unroll") for (int m = 0; m < 4; ++m) _Pragma("unroll") for (int n = 0; n < 2; ++n) _Pragma("unroll") for (int k = 0; k < 2; ++k) \
        acc[ai][bj][m][n] = __builtin_amdgcn_mfma_f32_16x16x32_bf16(Bt[n][k], At[m][k], acc[ai][bj][m][n], 0, 0, 0); __builtin_amdgcn_s_setprio(0); } while (0)
#define PG8_WAIT_V(n) asm volatile("s_waitcnt vmcnt(" #n ")" ::: "memory")
#define PG8_WAIT_L(n) asm volatile("s_waitcnt lgkmcnt(" #n ")" ::: "memory")
#define PG8_BAR __builtin_amdgcn_s_barrier()
#define PG8_SCHED __builtin_amdgcn_sched_barrier(0)
    Unit cur, nxt; int ui = 0;
    if (!S.next(0, cur)) return;
    Acc acc;
#pragma unroll
    for (int a = 0; a < 2; ++a)
#pragma unroll
        for (int b = 0; b < 2; ++b)
#pragma unroll
            for (int m = 0; m < 4; ++m)
#pragma unroll
                for (int n = 0; n < 2; ++n) acc[a][b][m][n] = (f32x4){0.f, 0.f, 0.f, 0.f};
    bf16x8 At[4][2], B0[2][2], B1[2][2];
    const char* cA = (const char*)g.A + (size_t)cur.pm * tstepA; const char* cB = (const char*)g.Bt + (size_t)cur.e * g.bstrideE + (size_t)cur.pn * tstepB;
    PG8_STAGE(PG8_SB(0, 0), cB, voffB); PG8_STAGE(PG8_SB(0, 1), cB + hstepB, voffB); PG8_STAGE(PG8_SA(0, 0), cA, voffA); PG8_STAGE(PG8_SA(0, 1), cA + hstepA, voffA);
    if (wr == 1) PG8_BAR;
    PG8_WAIT_V(2); PG8_BAR;
    PG8_STAGE(PG8_SB(1, 0), cB + kstep, voffB); PG8_STAGE(PG8_SA(1, 0), cA + kstep, voffA); PG8_STAGE(PG8_SB(1, 1), cB + hstepB + kstep, voffB);
    PG8_WAIT_V(6); PG8_BAR;
    for (;;) {
        const bool has_next = S.next(ui + 1, nxt);
        const char* nA = has_next ? (const char*)g.A + (size_t)nxt.pm * tstepA : cA;
        const char* nB = has_next ? (const char*)g.Bt + (size_t)nxt.e * g.bstrideE + (size_t)nxt.pn * tstepB : cB;
        for (int t = 0; t < nt; t += 2) {
            const bool last = (t == nt - 2);
            const char* a1 = cA + (size_t)(t + 1) * kstep;
            const char* a2 = last ? nA : cA + (size_t)(t + 2) * kstep; const char* b2 = last ? nB : cB + (size_t)(t + 2) * kstep;
            const char* a3 = a2 + kstep; const char* b3 = b2 + kstep;
            PG8_LDB(B0, 0, 0); PG8_LDB(B1, 0, 1); PG8_SCHED; PG8_LDA(At, 0, 0); PG8_STAGE(PG8_SA(1, 1), a1 + hstepA, voffA);
            PG8_WAIT_V(8); PG8_WAIT_L(0); PG8_BAR; PG8_MMA(0, 0, At, B0); PG8_MMA(0, 1, At, B1); PG8_BAR; PG8_SCHED;
            PG8_LDA(At, 0, 1); PG8_STAGE(PG8_SB(0, 0), b2, voffB); PG8_STAGE(PG8_SB(0, 1), b2 + hstepB, voffB); PG8_STAGE(PG8_SA(0, 0), a2, voffA);
            PG8_WAIT_V(8); PG8_WAIT_L(0); PG8_BAR; PG8_MMA(1, 0, At, B0); PG8_MMA(1, 1, At, B1); PG8_BAR; PG8_SCHED;
            PG8_LDB(B0, 1, 0); PG8_LDB(B1, 1, 1); PG8_SCHED; PG8_LDA(At, 1, 0); PG8_STAGE(PG8_SA(0, 1), a2 + hstepA, voffA);
            PG8_WAIT_V(8); PG8_WAIT_L(0); PG8_BAR; PG8_MMA(0, 0, At, B0); PG8_MMA(0, 1, At, B1); PG8_BAR; PG8_SCHED;
            PG8_LDA(At, 1, 1); PG8_STAGE(PG8_SB(1, 0), b3, voffB); PG8_STAGE(PG8_SB(1, 1), b3 + hstepB, voffB); PG8_STAGE(PG8_SA(1, 0), a3, voffA);
            PG8_WAIT_V(8); PG8_WAIT_L(0); PG8_BAR; PG8_MMA(1, 0, At, B0); PG8_MMA(1, 1, At, B1); PG8_BAR; PG8_SCHED;
        }
        if constexpr (ALIGN_EPI) { if (wr == 0) PG8_BAR; }
        E(acc, cur, wr, wc, fr, fq);
        if (!has_next) break;
#pragma unroll
        for (int a = 0; a < 2; ++a)
#pragma unroll
            for (int b = 0; b < 2; ++b)
#pragma unroll
                for (int m = 0; m < 4; ++m)
#pragma unroll
                    for (int n = 0; n < 2; ++n) acc[a][b][m][n] = (f32x4){0.f, 0.f, 0.f, 0.f};
        cur = nxt; cA = nA; cB = nB; ++ui;
        if constexpr (ALIGN_EPI) { if (wr == 1) PG8_BAR; }
    }
    PG8_WAIT_V(0);
    if constexpr (!ALIGN_EPI) { if (wr == 0) PG8_BAR; }
    PG8_BAR;
#undef PG8_SA
#undef PG8_SB
#undef PG8_STAGE
#undef PG8_LDA
#undef PG8_LDB
#undef PG8_MMA
#undef PG8_WAIT_V
#undef PG8_WAIT_L
#undef PG8_BAR
#undef PG8_SCHED
}

__device__ __forceinline__ u32x4 pack8(const f32x4 v0, const f32x4 v1) { u32x4 w; w.x = cvt_pk_bf16(v0[0], v0[1]); w.y = cvt_pk_bf16(v0[2], v0[3]); w.z = cvt_pk_bf16(v1[0], v1[1]); w.w = cvt_pk_bf16(v1[2], v1[3]); return w; }
__device__ __forceinline__ void unpack8(const u32x4 w, f32x4& v0, f32x4& v1) { v0 = (f32x4){bflo(w.x), bfhi(w.x), bflo(w.y), bfhi(w.y)}; v1 = (f32x4){bflo(w.z), bfhi(w.z), bflo(w.w), bfhi(w.w)}; }

struct EpiU { static constexpr bool PERM = true; bf16_t* U;
    __device__ __forceinline__ void operator()(const Acc& acc, const Unit& u, int wr, int wc, int fr, int fq) const {
        const int row0 = u.pm * BM + wr * 64 + fr, col0 = u.pn * BM + wc * 32 + 8 * fq;
        const int mode = u.pn < 2 ? 1 : (u.pn >= 5 ? 2 : 0);
#pragma unroll
        for (int ai = 0; ai < 2; ++ai)
#pragma unroll
            for (int m = 0; m < 4; ++m) { bf16_t* rowp = U + (size_t)(row0 + ai * HALF + m * 16) * INW + col0;
#pragma unroll
                for (int bj = 0; bj < 2; ++bj) { f32x4 v0 = acc[ai][bj][m][0], v1 = acc[ai][bj][m][1];
                    if (mode == 1) { v0 = v0 * 0.125f; v1 = v1 * 0.125f; }
                    else if (mode == 2) {
#pragma unroll
                        for (int j = 0; j < 4; ++j) { v0[j] = fast_sigmoid(v0[j]); v1[j] = fast_sigmoid(v1[j]); } }
                    *(u32x4*)(rowp + bj * HALF) = pack8(v0, v1); } }
    } };
struct EpiBrA { static constexpr bool PERM = true; const bf16_t* U; float* T;
    __device__ __forceinline__ void operator()(const Acc& acc, const Unit& u, int wr, int wc, int fr, int fq) const {
        const int row0 = u.pm * BM + wr * 64 + fr, col0 = u.pn * BM + wc * 32 + 8 * fq;
#pragma unroll
        for (int ai = 0; ai < 2; ++ai)
#pragma unroll
            for (int m = 0; m < 4; ++m) { const size_t row = (size_t)(row0 + ai * HALF + m * 16);
#pragma unroll
                for (int bj = 0; bj < 2; ++bj) { const int col = col0 + bj * HALF; f32x4 g0, g1; unpack8(*(const u32x4*)(U + row * INW + OGA + col), g0, g1);
                    float* tp = T + row * DM + col; *(f32x4*)tp = g0 * acc[ai][bj][m][0]; *(f32x4*)(tp + 4) = g1 * acc[ai][bj][m][1]; } }
    } };
struct EpiBrP { static constexpr bool PERM = true; const bf16_t* U; const float* T; bf16_t* MIX;
    __device__ __forceinline__ void operator()(const Acc& acc, const Unit& u, int wr, int wc, int fr, int fq) const {
        const int row0 = u.pm * BM + wr * 64 + fr, col0 = u.pn * BM + wc * 32 + 8 * fq;
#pragma unroll
        for (int ai = 0; ai < 2; ++ai)
#pragma unroll
            for (int m = 0; m < 4; ++m) { const size_t row = (size_t)(row0 + ai * HALF + m * 16);
#pragma unroll
                for (int bj = 0; bj < 2; ++bj) { const int col = col0 + bj * HALF; f32x4 g0, g1; unpack8(*(const u32x4*)(U + row * INW + OGP + col), g0, g1);
                    const float* tp = T + row * DM + col; const f32x4 t0 = *(const f32x4*)tp, t1 = *(const f32x4*)(tp + 4);
                    *(u32x4*)(MIX + row * DM + col) = pack8(t0 + g0 * acc[ai][bj][m][0], t1 + g1 * acc[ai][bj][m][1]); } }
    } };
struct EpiZ { static constexpr bool PERM = false; const float* x; float* Z;
    __device__ __forceinline__ void operator()(const Acc& acc, const Unit& u, int wr, int wc, int fr, int fq) const {
        const int row0 = u.pm * BM + wr * 64 + fr, col0 = u.pn * BM + wc * 32 + 4 * fq;
#pragma unroll
        for (int ai = 0; ai < 2; ++ai)
#pragma unroll
            for (int m = 0; m < 4; ++m) { const size_t off = (size_t)(row0 + ai * HALF + m * 16) * DM + col0;
#pragma unroll
                for (int bj = 0; bj < 2; ++bj)
#pragma unroll
                    for (int n = 0; n < 2; ++n) { const f32x4 xv = *(const f32x4*)(x + off + bj * HALF + n * 16); *(f32x4*)(Z + off + bj * HALF + n * 16) = xv * ALPHA + acc[ai][bj][m][n]; } }
    } };
struct EpiAct { static constexpr bool PERM = true; const float* b1; bf16_t* ACT;
    __device__ __forceinline__ void operator()(const Acc& acc, const Unit& u, int wr, int wc, int fr, int fq) const {
        const int row0 = u.pm * BM + wr * 64 + fr, j0 = u.pn * HALF + wc * 32 + 8 * fq;
        const float* bp = b1 + (size_t)u.e * 2 * DE + j0;
        const f32x4 bg0 = *(const f32x4*)bp, bg1 = *(const f32x4*)(bp + 4), bu0 = *(const f32x4*)(bp + DE), bu1 = *(const f32x4*)(bp + DE + 4);
#pragma unroll
        for (int ai = 0; ai < 2; ++ai)
#pragma unroll
            for (int m = 0; m < 4; ++m) {
                f32x4 o[2];
#pragma unroll
                for (int n = 0; n < 2; ++n) { const f32x4 hg = acc[ai][0][m][n] + (n ? bg1 : bg0), hu = acc[ai][1][m][n] + (n ? bu1 : bu0);
#pragma unroll
                    for (int j = 0; j < 4; ++j) { const float gate = fminf(hg[j], 7.0f), up = fminf(fmaxf(hu[j], -7.0f), 7.0f); o[n][j] = (up + 1.0f) * gate * fast_sigmoid(1.702f * gate); } }
                *(u32x4*)(ACT + (size_t)(row0 + ai * HALF + m * 16) * DE + j0) = pack8(o[0], o[1]); }
    } };
struct EpiY { static constexpr bool PERM = true; const float* b2; bf16_t* YB;
    __device__ __forceinline__ void operator()(const Acc& acc, const Unit& u, int wr, int wc, int fr, int fq) const {
        const int row0 = u.pm * BM + wr * 64 + fr, col0 = u.pn * BM + wc * 32 + 8 * fq;
        const float* bp = b2 + (size_t)u.e * DM + col0;
        f32x4 bv[2][2];
#pragma unroll
        for (int bj = 0; bj < 2; ++bj) { bv[bj][0] = *(const f32x4*)(bp + bj * HALF); bv[bj][1] = *(const f32x4*)(bp + bj * HALF + 4); }
#pragma unroll
        for (int ai = 0; ai < 2; ++ai)
#pragma unroll
            for (int m = 0; m < 4; ++m) { bf16_t* rowp = YB + (size_t)(row0 + ai * HALF + m * 16) * DM + col0;
#pragma unroll
                for (int bj = 0; bj < 2; ++bj) *(u32x4*)(rowp + bj * HALF) = pack8(acc[ai][bj][m][0] + bv[bj][0], acc[ai][bj][m][1] + bv[bj][1]); }
    } };
}

__device__ __forceinline__ void p0_item(const float* W, int N, int k0, int n0, bf16_t* WT, int ldt, int drow0, int dk0, LAS float* scr, int lane) {
#pragma unroll 8
    for (int i = 0; i < 32; ++i) { const int kk = 2 * i + (lane >> 5); scr[kk * 33 + (lane & 31)] = W[(size_t)(k0 + kk) * N + n0 + (lane & 31)]; }
    asm volatile("s_waitcnt lgkmcnt(0)" ::: "memory");
    const int c = lane & 7;
#pragma unroll
    for (int j = 0; j < 4; ++j) { const int n = (lane >> 3) + 8 * j; const LAS float* s = scr + (8 * c) * 33 + n;
        u32x4 o; o.x = cvt_pk_bf16(s[0 * 33], s[1 * 33]); o.y = cvt_pk_bf16(s[2 * 33], s[3 * 33]); o.z = cvt_pk_bf16(s[4 * 33], s[5 * 33]); o.w = cvt_pk_bf16(s[6 * 33], s[7 * 33]);
        *(u32x4*)(WT + (size_t)(drow0 + n) * ldt + dk0 + k0 + 8 * c) = o; }
    asm volatile("s_waitcnt lgkmcnt(0)" ::: "memory");
}


__device__ __forceinline__ int crow(int r, int hi) { return (r & 3) + 8 * (r >> 2) + 4 * hi; }
constexpr int KS_STRIDE = 144, VT_STRIDE = 776, ATT_VT_OFF = 384 * KS_STRIDE, ATT_SC_OFF = ATT_VT_OFF + 64 * VT_STRIDE;
__device__ __forceinline__ void attn_unit(LAS unsigned char* lds, const bf16_t* __restrict__ U, const float* __restrict__ sinks, bf16_t* __restrict__ AY, int unit, int tid, int wave, int lane) {
    const int kvh = unit & 1, blk = (unit >> 1) & 63, b = unit >> 7;
    const int tok0 = b * SEQ + blk * 128;
    LAS unsigned char* Ks = lds; LAS unsigned char* Vt = lds + ATT_VT_OFF; LAS float* lsc = (LAS float*)(lds + ATT_SC_OFF) + wave * 64;
    for (int p = tid; p < 3072; p += 512) {
        const int row = p >> 3, c8 = p & 7, kb = blk - 1 + (row >> 7); u32x4 v = (u32x4){0u, 0u, 0u, 0u};
        if (kb >= 0 && kb < SEQ / 128) v = *(const u32x4*)(U + (size_t)(b * SEQ + kb * 128 + (row & 127)) * INW + OKK + kvh * 64 + 8 * c8);
        *(LAS u32x4*)(Ks + row * KS_STRIDE + c8 * 16) = v;
    }
    for (int pp = tid; pp < 1536; pp += 512) {
        const int kp = pp >> 3, dc = pp & 7, row = 2 * kp, kb = blk - 1 + (row >> 7); u32x4 v0 = (u32x4){0u, 0u, 0u, 0u}, v1 = v0;
        if (kb >= 0 && kb < SEQ / 128) { const bf16_t* src = U + (size_t)(b * SEQ + kb * 128 + (row & 127)) * INW + OV + kvh * 64 + 8 * dc; v0 = *(const u32x4*)src; v1 = *(const u32x4*)(src + INW); }
        LAS unsigned char* dst = Vt + (8 * dc) * VT_STRIDE + kp * 4;
#pragma unroll
        for (int i = 0; i < 4; ++i) {
            const unsigned w0 = v0[i], w1 = v1[i];
            *(LAS unsigned*)(dst + (2 * i) * VT_STRIDE) = (w0 & 0xffffu) | (w1 << 16);
            *(LAS unsigned*)(dst + (2 * i + 1) * VT_STRIDE) = (w0 >> 16) | (w1 & 0xffff0000u);
        }
    }
    __syncthreads();
    const int g = wave >> 1, qh = wave & 1, h = 4 * kvh + g, l31 = lane & 31, hh = lane >> 5;
    const float slope = exp2f(-(float)(h + 1)), sink = sinks[h];
    bf16x8 qf[2][4];
#pragma unroll
    for (int qb = 0; qb < 2; ++qb)
#pragma unroll
        for (int s4 = 0; s4 < 4; ++s4) qf[qb][s4] = *(const bf16x8*)(U + (size_t)(tok0 + 64 * qh + 32 * qb + l31) * INW + OQ + h * 64 + 16 * s4 + 8 * hh);
    const int kt0 = qh ? 2 : 0, kt1 = qh ? 12 : 10;
    const int kabs0 = (blk - 1) * 128;
    float mx[2] = {sink, sink};
    for (int kt = kt0; kt < kt1; ++kt) {
        bf16x8 kf[4];
#pragma unroll
        for (int s4 = 0; s4 < 4; ++s4) kf[s4] = *(const LAS bf16x8*)(Ks + (kt * 32 + l31) * KS_STRIDE + (16 * s4 + 8 * hh) * 2);
#pragma unroll
        for (int qb = 0; qb < 2; ++qb) {
            f32x16 sa;
#pragma unroll
            for (int r = 0; r < 16; ++r) sa[r] = 0.f;
#pragma unroll
            for (int s4 = 0; s4 < 4; ++s4) sa = __builtin_amdgcn_mfma_f32_32x32x16_bf16(kf[s4], qf[qb][s4], sa, 0, 0, 0);
            const int aq = 64 * qh + 32 * qb + l31;
#pragma unroll
            for (int r = 0; r < 16; ++r) {
                const int kk = kt * 32 + crow(r, hh), rel = kk - 128 - aq, ar = rel < 0 ? -rel : rel, kabs = kabs0 + kk;
                const bool valid = (ar <= 128) && (kabs >= 0) && (kabs < SEQ);
                const float sv = valid ? sa[r] - slope * (float)ar : -INFINITY;
                mx[qb] = fmaxf(mx[qb], sv);
            }
        }
    }
    mx[0] = fmaxf(mx[0], __shfl_xor(mx[0], 32)); mx[1] = fmaxf(mx[1], __shfl_xor(mx[1], 32));
    const float L2E = 1.4426950408889634f;
    float lsum[2] = {0.f, 0.f};
    f32x16 o[2][2];
#pragma unroll
    for (int qb = 0; qb < 2; ++qb)
#pragma unroll
        for (int db = 0; db < 2; ++db)
#pragma unroll
            for (int r = 0; r < 16; ++r) o[qb][db][r] = 0.f;
    for (int kt = kt0; kt < kt1; ++kt) {
        bf16x8 kf[4];
#pragma unroll
        for (int s4 = 0; s4 < 4; ++s4) kf[s4] = *(const LAS bf16x8*)(Ks + (kt * 32 + l31) * KS_STRIDE + (16 * s4 + 8 * hh) * 2);
        bf16x8 vf[2][2];
#pragma unroll
        for (int db = 0; db < 2; ++db)
#pragma unroll
            for (int s2 = 0; s2 < 2; ++s2) {
                const LAS unsigned char* vp = Vt + (32 * db + l31) * VT_STRIDE + (kt * 32 + 16 * s2 + 4 * hh) * 2;
                const u32x2 lo = *(const LAS u32x2*)vp, hi2 = *(const LAS u32x2*)(vp + 16);
                u32x4 w = (u32x4){lo.x, lo.y, hi2.x, hi2.y}; vf[db][s2] = __builtin_bit_cast(bf16x8, w);
            }
#pragma unroll
        for (int qb = 0; qb < 2; ++qb) {
            f32x16 sa;
#pragma unroll
            for (int r = 0; r < 16; ++r) sa[r] = 0.f;
#pragma unroll
            for (int s4 = 0; s4 < 4; ++s4) sa = __builtin_amdgcn_mfma_f32_32x32x16_bf16(kf[s4], qf[qb][s4], sa, 0, 0, 0);
            const int aq = 64 * qh + 32 * qb + l31; const float mq = mx[qb] * L2E;
            float ls = 0.f;
#pragma unroll
            for (int r = 0; r < 16; ++r) {
                const int kk = kt * 32 + crow(r, hh), rel = kk - 128 - aq, ar = rel < 0 ? -rel : rel, kabs = kabs0 + kk;
                const bool valid = (ar <= 128) && (kabs >= 0) && (kabs < SEQ);
                const float sv = valid ? sa[r] - slope * (float)ar : -INFINITY;
                const float pe = __builtin_amdgcn_exp2f(sv * L2E - mq);
                sa[r] = pe; ls += pe;
            }
            lsum[qb] += ls;
#pragma unroll
            for (int s2 = 0; s2 < 2; ++s2) {
                u32x4 w; w.x = cvt_pk_bf16(sa[8 * s2 + 0], sa[8 * s2 + 1]); w.y = cvt_pk_bf16(sa[8 * s2 + 2], sa[8 * s2 + 3]); w.z = cvt_pk_bf16(sa[8 * s2 + 4], sa[8 * s2 + 5]); w.w = cvt_pk_bf16(sa[8 * s2 + 6], sa[8 * s2 + 7]);
                const bf16x8 pa = __builtin_bit_cast(bf16x8, w);
#pragma unroll
                for (int db = 0; db < 2; ++db) o[qb][db] = __builtin_amdgcn_mfma_f32_32x32x16_bf16(pa, vf[db][s2], o[qb][db], 0, 0, 0);
            }
        }
    }
#pragma unroll
    for (int qb = 0; qb < 2; ++qb) { const float lt = lsum[qb] + __shfl_xor(lsum[qb], 32) + __builtin_amdgcn_exp2f((sink - mx[qb]) * L2E); if (hh == 0) lsc[qb * 32 + l31] = 1.0f / lt; }
    asm volatile("s_waitcnt lgkmcnt(0)" ::: "memory");
#pragma unroll
    for (int qb = 0; qb < 2; ++qb)
#pragma unroll
        for (int r = 0; r < 16; ++r) { const int q = crow(r, hh); const float li = lsc[qb * 32 + q];
            bf16_t* op = AY + (size_t)(tok0 + 64 * qh + 32 * qb + q) * DM + h * 64 + l31;
            op[0] = f2bf(o[qb][0][r] * li); op[32] = f2bf(o[qb][1][r] * li); }
    __syncthreads();
}

constexpr int PL_STRIDE = 272, PL_YS_OFF = 144 * PL_STRIDE, PL_WS_OFF = PL_YS_OFF + 128 * PL_STRIDE;
__device__ __forceinline__ void pool_unit(LAS unsigned char* lds, const bf16_t* __restrict__ U, const bf16_t* __restrict__ Wgt, const float* __restrict__ pscale, bf16_t* __restrict__ AY, int unit, int tid, int wave, int lane) {
    const int g = unit & 3, tt = unit >> 2, tok0 = tt * 128, b = tok0 / SEQ, t0 = tok0 % SEQ;
    LAS unsigned char* Ps = lds; LAS unsigned char* Ys = lds + PL_YS_OFF; LAS unsigned char* Ws = lds + PL_WS_OFF;
    for (int p = tid; p < 144 * 16; p += 512) {
        const int lr = p >> 4, c8 = p & 15, t = t0 - 8 + lr; u32x4 v = (u32x4){0u, 0u, 0u, 0u};
        if (t >= 0 && t < SEQ) v = *(const u32x4*)(U + (size_t)(b * SEQ + t) * INW + OP + 128 * g + 8 * c8);
        *(LAS u32x4*)(Ps + lr * PL_STRIDE + c8 * 16) = v;
    }
    for (int p = tid; p < 2048; p += 512) { const int r = p >> 4, c8 = p & 15; *(LAS u32x4*)(Ws + r * PL_STRIDE + c8 * 16) = *(const u32x4*)(Wgt + (size_t)(g * 128 + r) * 128 + 8 * c8); }
    __syncthreads();
    const int hw = 1 << g;
    for (int p = tid; p < 2048; p += 512) {
        const int tl = p >> 4, c8 = p & 15, t = t0 + tl, lo = max(t - hw, 0), hi = min(t + hw - 1, SEQ - 1);
        f32x4 s0 = (f32x4){0.f, 0.f, 0.f, 0.f}, s1 = s0;
        for (int q = lo; q <= hi; ++q) { f32x4 a0, a1; pg8::unpack8(*(const LAS u32x4*)(Ps + (q - t0 + 8) * PL_STRIDE + c8 * 16), a0, a1); s0 = s0 + a0; s1 = s1 + a1; }
        const float inv = 1.0f / (float)(hi - lo + 1);
        f32x4 p0, p1; pg8::unpack8(*(const LAS u32x4*)(Ps + (tl + 8) * PL_STRIDE + c8 * 16), p0, p1);
        *(LAS u32x4*)(Ys + tl * PL_STRIDE + c8 * 16) = pg8::pack8(s0 * inv - p0, s1 * inv - p1);
    }
    __syncthreads();
    const int wr = wave >> 1, wc = wave & 1, fr = lane & 15, fq = lane >> 4;
    f32x4 acc[2][4];
#pragma unroll
    for (int m = 0; m < 2; ++m)
#pragma unroll
        for (int n = 0; n < 4; ++n) acc[m][n] = (f32x4){0.f, 0.f, 0.f, 0.f};
#pragma unroll
    for (int ks = 0; ks < 4; ++ks) {
        bf16x8 af[2], bfr[4];
#pragma unroll
        for (int m = 0; m < 2; ++m) af[m] = *(const LAS bf16x8*)(Ys + (32 * wr + 16 * m + fr) * PL_STRIDE + (32 * ks + 8 * fq) * 2);
#pragma unroll
        for (int n = 0; n < 4; ++n) bfr[n] = *(const LAS bf16x8*)(Ws + (64 * wc + 16 * n + fr) * PL_STRIDE + (32 * ks + 8 * fq) * 2);
#pragma unroll
        for (int m = 0; m < 2; ++m)
#pragma unroll
            for (int n = 0; n < 4; ++n) acc[m][n] = __builtin_amdgcn_mfma_f32_16x16x32_bf16(bfr[n], af[m], acc[m][n], 0, 0, 0);
    }
#pragma unroll
    for (int m = 0; m < 2; ++m)
#pragma unroll
        for (int n = 0; n < 4; ++n) { const int d = 64 * wc + 16 * n + 4 * fq; const f32x4 v = acc[m][n] * *(const f32x4*)(pscale + 128 * g + d);
            u32x2 o2; o2.x = cvt_pk_bf16(v[0], v[1]); o2.y = cvt_pk_bf16(v[2], v[3]);
            *(u32x2*)(AY + (size_t)(tok0 + 32 * wr + 16 * m + fr) * DM + 512 + 128 * g + d) = o2; }
    __syncthreads();
}

struct MArgs { const float* in[18]; float* out; unsigned char* ws; int ph_lo, ph_hi, li, pad; };

__global__ void __launch_bounds__(NWAVES * 64, 2) mega(MArgs a) {
    extern __shared__ __attribute__((aligned(16))) unsigned char lds_raw[];
    LAS unsigned char* lds = (LAS unsigned char*)lds_raw;
    volatile LAS unsigned* XW = (volatile LAS unsigned*)(lds + LDSX_OFF);
    const int tid = threadIdx.x, lane = tid & 63, wave = __builtin_amdgcn_readfirstlane(tid >> 6);
    const int G = gridDim.x, bx = blockIdx.x;
    const int vcu = (G % 8 == 0) ? (bx % 8) * (G / 8) + bx / 8 : bx;
    unsigned char* ws = a.ws;
    unsigned* ctl = (unsigned*)(ws + WS_CTL);
    bf16_t* U = (bf16_t*)(ws + WS_U); bf16_t* AY = (bf16_t*)(ws + WS_AY); bf16_t* MIX = (bf16_t*)(ws + WS_MIX); bf16_t* XB = (bf16_t*)(ws + WS_XB);
    float* Z = (float*)(ws + WS_Z); bf16_t* XS = (bf16_t*)(ws + WS_XS); bf16_t* ACT = (bf16_t*)(ws + WS_ACT); float* T = (float*)(ws + WS_ACT); bf16_t* YB = XS;
    bf16_t* Wint = (bf16_t*)(ws + WS_WIN); bf16_t* Wab = (bf16_t*)(ws + WS_WAB); bf16_t* Wot = (bf16_t*)(ws + WS_WO); bf16_t* W1t = (bf16_t*)(ws + WS_W1); bf16_t* W2t = (bf16_t*)(ws + WS_W2); bf16_t* Wgt = (bf16_t*)(ws + WS_WG);
    float* WgT = (float*)(ws + WS_WR); bf16_t* H1B = (bf16_t*)(ws + WS_H1B); float* STAT = (float*)(ws + WS_STAT);
    int* te = (int*)(ws + WS_TE); float* tg = (float*)(ws + WS_TG); int* tr = (int*)(ws + WS_TR); int* td = (int*)(ws + WS_TD);
    if (tid < 16) XW[tid] = 0u;
    __syncthreads();
    XcdBarrier bar = xcd_barrier_post(ctl + CW_BAR + a.li * XCD_BAR_WORDS, XW);
    const int lo = a.ph_lo, hi = a.ph_hi;
#define IN(k) (lo <= (k) && (k) < hi)
#define SEAM(k) do { if (IN(k) && IN((k) + 1)) xcd_barrier(bar); } while (0)

    if (IN(0)) {
        LAS float* scr = (LAS float*)(lds + wave * 16384);
        const int gw = vcu * NWAVES + wave, NGW = G * NWAVES;
        constexpr int I_IN = (DM / 64) * (INW / 32), I_AB = (512 / 64) * (DM / 32), I_O = (DM / 64) * (DM / 32), I_1 = (DM / 64) * (2 * DE / 32), I_2 = (DE / 64) * (DM / 32);
        constexpr int I_G = (128 / 64) * (128 / 32);
        constexpr int NITEMS = I_IN + 2 * I_AB + I_O + 4 * I_G + NE * (I_1 + I_2);
        for (int it = gw; it < NITEMS; it += NGW) {
            int r = it;
            if (r < I_IN) { const int nb = INW / 32; p0_item(a.in[1], INW, 64 * (r / nb), 32 * (r % nb), Wint, DM, 32 * (r % nb), 0, scr, lane); continue; } r -= I_IN;
            if (r < I_AB) { const int nb = DM / 32; p0_item(a.in[3], DM, 64 * (r / nb), 32 * (r % nb), Wab, DM, 32 * (r % nb), 0, scr, lane); continue; } r -= I_AB;
            if (r < I_AB) { const int nb = DM / 32; p0_item(a.in[6], DM, 64 * (r / nb), 32 * (r % nb), Wab, DM, 32 * (r % nb), 512, scr, lane); continue; } r -= I_AB;
            if (r < I_O) { const int nb = DM / 32; p0_item(a.in[7], DM, 64 * (r / nb), 32 * (r % nb), Wot, DM, 32 * (r % nb), 0, scr, lane); continue; } r -= I_O;
            if (r < 4 * I_G) { const int gg = r / I_G, q = r % I_G; p0_item(a.in[4] + (size_t)gg * 128 * 128, 128, 64 * (q / 4), 32 * (q % 4), Wgt + (size_t)gg * 128 * 128, 128, 32 * (q % 4), 0, scr, lane); continue; } r -= 4 * I_G;
            if (r < NE * I_1) { const int e = r / I_1, q = r % I_1, nb = 2 * DE / 32, n0 = 32 * (q % nb);
                const int drow = n0 < DE ? 256 * (n0 >> 7) + (n0 & 127) : 256 * ((n0 - DE) >> 7) + 128 + ((n0 - DE) & 127);
                p0_item(a.in[12] + (size_t)e * DM * 2 * DE, 2 * DE, 64 * (q / nb), n0, W1t + (size_t)e * 2 * DE * DM, DM, drow, 0, scr, lane); continue; } r -= NE * I_1;
            { const int e = r / I_2, q = r % I_2, nb = DM / 32; p0_item(a.in[14] + (size_t)e * DE * DM, DM, 64 * (q / nb), 32 * (q % nb), W2t + (size_t)e * DM * DE, DE, 32 * (q % nb), 0, scr, lane); }
        }
        {
            const float* g1 = a.in[8]; const float* b1 = a.in[9]; const float* wr = a.in[10]; const float* br = a.in[11];
            for (int i = gw * 64 + lane; i < NE * DM; i += NGW * 64) { const int e = i >> 10, c = i & 1023; WgT[i] = g1[c] * wr[c * NE + e]; }
            if (gw < 64) { const int e = gw & 31, which = gw >> 5; float sacc = 0.f;
                for (int c = lane; c < DM; c += 64) sacc += (which ? b1[c] : g1[c]) * wr[c * NE + e];
                sacc = wave_sum(sacc);
                if (lane == 0) { if (which) WgT[NE * DM + 32 + e] = sacc + br[e]; else WgT[NE * DM + e] = sacc; } }
        }
        const float* x = a.in[0];
        for (size_t i = ((size_t)gw * 64 + lane) * 8; i < (size_t)NTOK * DM; i += (size_t)NGW * 64 * 8) {
            const f32x4 v0 = *(const f32x4*)(x + i), v1 = *(const f32x4*)(x + i + 4);
            *(u32x4*)(XB + i) = pg8::pack8(v0, v1); }
    }
    SEAM(0);
    if (IN(1)) {
        pg8::Gemm g{XB, Wint, DM, DM, DM, 0}; pg8::StaticOrder S; S.init(NTOK, INW, G, bx, 8);
        pg8::gemm_phase<pg8::EpiU, pg8::StaticOrder, true>(lds, g, S, pg8::EpiU{U});
    }
    SEAM(1);
    if (IN(2)) {
        for (int unit = vcu; unit < 2 * (SEQ / 128) * 2; unit += G) attn_unit(lds, U, a.in[2], AY, unit, tid, wave, lane);
        for (int unit = vcu; unit < (NTOK / 128) * 4; unit += G) pool_unit(lds, U, Wgt, a.in[5], AY, unit, tid, wave, lane);
    }
    SEAM(2);
    if (IN(3)) {
        pg8::StaticOrder S; S.init(NTOK, DM, G, bx, 8);
        { pg8::Gemm g{AY, Wab, 512, DM, DM, 0}; pg8::gemm_phase<pg8::EpiBrA, pg8::StaticOrder, true>(lds, g, S, pg8::EpiBrA{U, T}); }
        asm volatile("s_waitcnt vmcnt(0)" ::: "memory"); __syncthreads();
        { pg8::Gemm g{AY + 512, Wab + 512, 512, DM, DM, 0}; pg8::gemm_phase<pg8::EpiBrP, pg8::StaticOrder, true>(lds, g, S, pg8::EpiBrP{U, T, MIX}); }
    }
    SEAM(3);
    if (IN(4)) {
        pg8::Gemm g{MIX, Wot, DM, DM, DM, 0}; pg8::StaticOrder S; S.init(NTOK, DM, G, bx, 8);
        pg8::gemm_phase<pg8::EpiZ, pg8::StaticOrder, true>(lds, g, S, pg8::EpiZ{a.in[0], Z});
    }
    SEAM(4);
    if (IN(5)) {
        const float* g1 = a.in[8]; const float* b1 = a.in[9];
        LAS float* part = (LAS float*)lds;
        LAS float* stat = (LAS float*)(lds + 40960);
        LAS float* lgs = (LAS float*)(lds + 49152);
        LAS int* lcnt = (LAS int*)(lds + 61440);
        for (int tile = bx; tile < NTOK / 64; tile += G) {
            if (tid < 64) lcnt[tid] = 0;
            for (int i = 0; i < 8; ++i) {
                const int r = 8 * wave + i, tok = tile * 64 + r; f32x4 v[4]; float sacc = 0.f;
#pragma unroll
                for (int j = 0; j < 4; ++j) { v[j] = *(const f32x4*)(Z + (size_t)tok * DM + 256 * j + 4 * lane); sacc += (v[j][0] + v[j][1]) + (v[j][2] + v[j][3]); }
                const float mean = wave_sum(sacc) * (1.0f / DM); float q = 0.f;
#pragma unroll
                for (int j = 0; j < 4; ++j) { v[j] = v[j] - mean; q += (v[j][0] * v[j][0] + v[j][1] * v[j][1]) + (v[j][2] * v[j][2] + v[j][3] * v[j][3]); }
                const float rstd = rsqrtf(wave_sum(q) * (1.0f / DM) + LN_EPS);
#pragma unroll
                for (int j = 0; j < 4; ++j) { const f32x4 hv = v[j] * rstd * *(const f32x4*)(g1 + 256 * j + 4 * lane) + *(const f32x4*)(b1 + 256 * j + 4 * lane);
                    u32x2 o; o.x = cvt_pk_bf16(hv[0], hv[1]); o.y = cvt_pk_bf16(hv[2], hv[3]); *(u32x2*)(H1B + (size_t)tok * DM + 256 * j + 4 * lane) = o; }
                if (lane == 0) { stat[2 * r] = mean; stat[2 * r + 1] = rstd; STAT[2 * tok] = mean; STAT[2 * tok + 1] = rstd; }
            }
            {
                const int tt = wave >> 2, kq = wave & 3, half = lane >> 5, j32 = lane & 31;
                const float* zr = Z + (size_t)(tile * 64 + 32 * tt + j32) * DM + 256 * kq + 4 * half;
                const float* wrow = WgT + (size_t)j32 * DM + 256 * kq + 4 * half;
                f32x16 acc;
#pragma unroll
                for (int r = 0; r < 16; ++r) acc[r] = 0.f;
#pragma unroll 4
                for (int g = 0; g < 32; ++g) { const f32x4 av = *(const f32x4*)(zr + 8 * g), bv = *(const f32x4*)(wrow + 8 * g);
#pragma unroll
                    for (int ii = 0; ii < 4; ++ii) acc = __builtin_amdgcn_mfma_f32_32x32x2f32(av[ii], bv[ii], acc, 0, 0, 0); }
#pragma unroll
                for (int r = 0; r < 16; ++r) part[((tt * 4 + kq) * 32 + ((r & 3) + 8 * (r >> 2) + 4 * half)) * 33 + j32] = acc[r];
            }
            __syncthreads();
            if (wave == 0) {
                const int t = lane, tok = tile * 64 + t; const float mean = stat[2 * t], rstd = stat[2 * t + 1];
                const LAS float* pp = part + ((t >> 5) * 4 * 32 + (t & 31)) * 33;
                for (int e = 0; e < NE; ++e) { const float sv = (pp[e] + pp[32 * 33 + e]) + (pp[2 * 32 * 33 + e] + pp[3 * 32 * 33 + e]);
                    lgs[t * 33 + e] = rstd * (sv - mean * WgT[NE * DM + e]) + WgT[NE * DM + 32 + e]; }
                float sv[4]; int se[4];
#pragma unroll
                for (int k = 0; k < 4; ++k) { float best = -INFINITY; int bi = 0;
                    for (int e = 0; e < NE; ++e) { const float xv = lgs[t * 33 + e]; if (xv > best) { best = xv; bi = e; } }
                    sv[k] = best; se[k] = bi; lgs[t * 33 + bi] = -INFINITY; }
                float ex[4], sum = 0.f; int rl[4];
#pragma unroll
                for (int k = 0; k < 4; ++k) { ex[k] = __expf(sv[k] - sv[0]); sum += ex[k]; rl[k] = atomicAdd((int*)&lcnt[se[k]], 1); }
                asm volatile("s_waitcnt lgkmcnt(0)" ::: "memory");
                if (lane < 32) lcnt[32 + lane] = atomicAdd((int*)&ctl[lane], lcnt[lane]);
                asm volatile("s_waitcnt vmcnt(0) lgkmcnt(0)" ::: "memory");
                const float rs = 1.0f / sum;
#pragma unroll
                for (int k = 0; k < 4; ++k) { te[tok * 4 + k] = se[k]; tg[tok * 4 + k] = ex[k] * rs; tr[tok * 4 + k] = lcnt[32 + se[k]] + rl[k]; }
            }
            __syncthreads();
        }
    }
    SEAM(5);
    if (IN(6)) {
        LAS int* pst = (LAS int*)(lds + LDSX_OFF + 2048);
        if (tid == 0) { int ps = 0; for (int e = 0; e < NE; ++e) { pst[e] = ps; ps += (((int)ctl[e] + 255) >> 8) << 8; } }
        __syncthreads();
        const int gw = vcu * NWAVES + wave, NGW = G * NWAVES;
        for (int as = gw; as < NTOK * TOPK; as += NGW) {
            const int tok = as >> 2, dest = pst[te[as]] + tr[as];
            if (lane == 0) td[as] = dest;
            const u32x4* src = (const u32x4*)(H1B + (size_t)tok * DM); u32x4* dst = (u32x4*)(XS + (size_t)dest * DM);
            dst[lane] = src[lane]; dst[64 + lane] = src[64 + lane];
        }
    }
    SEAM(6);
    if (IN(7) || IN(8)) {
        LAS int* tile_e = (LAS int*)(lds + LDSX_OFF + 256);
        if (tid == 0) { int ps = 0; for (int e = 0; e < NE; ++e) { const int nt = ((int)ctl[e] + 255) >> 8; for (int i = 0; i < nt; ++i) tile_e[1 + ps + i] = e; ps += nt; } tile_e[0] = ps; }
        __syncthreads();
        const int nT = tile_e[0];
        if (IN(7)) {
            pg8::Gemm g{XS, W1t, DM, DM, DM, (size_t)2 * DE * DM * 2}; pg8::MoeOrder S{nT, DE / 128, nT * (DE / 128), G, bx, tile_e + 1};
            pg8::gemm_phase<pg8::EpiAct, pg8::MoeOrder, true>(lds, g, S, pg8::EpiAct{a.in[13], ACT});
        }
        SEAM(7);
        if (IN(8)) {
            pg8::Gemm g{ACT, W2t, DE, DE, DE, (size_t)DM * DE * 2}; pg8::MoeOrder S{nT, DM / 256, nT * (DM / 256), G, bx, tile_e + 1};
            pg8::gemm_phase<pg8::EpiY, pg8::MoeOrder, true>(lds, g, S, pg8::EpiY{a.in[15], YB});
        }
    }
    SEAM(8);
    if (IN(9)) {
        const float* g1 = a.in[8]; const float* b1 = a.in[9]; const float* g2 = a.in[16]; const float* b2 = a.in[17];
        const int gw = vcu * NWAVES + wave, NGW = G * NWAVES;
        for (int tok = gw; tok < NTOK; tok += NGW) {
            const float mean1 = STAT[2 * tok], rstd1 = STAT[2 * tok + 1];
            int dk[4]; float wk[4];
#pragma unroll
            for (int k = 0; k < 4; ++k) { dk[k] = td[tok * 4 + k]; wk[k] = tg[tok * 4 + k]; }
            f32x4 v[4]; float sacc = 0.f;
#pragma unroll
            for (int j = 0; j < 4; ++j) { const int c = 256 * j + 4 * lane;
                const f32x4 z = *(const f32x4*)(Z + (size_t)tok * DM + c);
                f32x4 h1 = (z - mean1) * rstd1 * *(const f32x4*)(g1 + c) + *(const f32x4*)(b1 + c);
                f32x4 f = (f32x4){0.f, 0.f, 0.f, 0.f};
#pragma unroll
                for (int k = 0; k < 4; ++k) { const u32x2 y = *(const u32x2*)(YB + (size_t)dk[k] * DM + c); f = f + wk[k] * (f32x4){bflo(y.x), bfhi(y.x), bflo(y.y), bfhi(y.y)}; }
                v[j] = ALPHA * h1 + f; sacc += (v[j][0] + v[j][1]) + (v[j][2] + v[j][3]); }
            const float mean = wave_sum(sacc) * (1.0f / DM); float q = 0.f;
#pragma unroll
            for (int j = 0; j < 4; ++j) { v[j] = v[j] - mean; q += (v[j][0] * v[j][0] + v[j][1] * v[j][1]) + (v[j][2] * v[j][2] + v[j][3] * v[j][3]); }
            const float rstd = rsqrtf(wave_sum(q) * (1.0f / DM) + LN_EPS);
#pragma unroll
            for (int j = 0; j < 4; ++j) { const int c = 256 * j + 4 * lane; *(f32x4*)(a.out + (size_t)tok * DM + c) = v[j] * rstd * *(const f32x4*)(g2 + c) + *(const f32x4*)(b2 + c); }
        }
    }
#undef IN
#undef SEAM
}

extern "C" void kernel_launch(void* const* d_in, const int* in_sizes, int n_in, void* d_out, int out_size, void* d_ws, size_t ws_size, hipStream_t stream) {
    static int grid = 0;
    if (grid == 0) {
        if (n_in != 18 || ws_size < WS_END) { fprintf(stderr, "kernel_launch: unexpected n_in %d / ws_size %zu (need %zu)\n", n_in, ws_size, (size_t)WS_END); grid = -1; return; }
        int dev = 0, cus = 0;
        if (hipGetDevice(&dev) != hipSuccess || hipDeviceGetAttribute(&cus, hipDeviceAttributeMultiprocessorCount, dev) != hipSuccess) { grid = -1; return; }
        if (hipFuncSetAttribute((const void*)mega, hipFuncAttributeMaxDynamicSharedMemorySize, LDS_BYTES) != hipSuccess) { fprintf(stderr, "kernel_launch: hipFuncSetAttribute failed\n"); grid = -1; return; }
        grid = cus;
    }
    if (grid < 0) return;
    const float* x = (const float*)d_in[0]; const float* sinks = (const float*)d_in[2];
    const float* w_pg = (const float*)d_in[4]; const float* pscale = (const float*)d_in[5];
    const float* ln1g = (const float*)d_in[8]; const float* ln1b = (const float*)d_in[9]; const float* w_r = (const float*)d_in[10]; const float* b_r = (const float*)d_in[11];
    const float* ln2g = (const float*)d_in[16]; const float* ln2b = (const float*)d_in[17];
    char* ws = (char*)d_ws; float* out = (float*)d_out;
    int* ctl = (int*)(ws + WS_CTL); bf16_t* U = (bf16_t*)(ws + WS_U); bf16_t* AY = (bf16_t*)(ws + WS_AY);
    bf16_t* H1B = (bf16_t*)(ws + WS_H1B); float* Z = (float*)(ws + WS_Z); float* STAT = (float*)(ws + WS_STAT);
    int* te = (int*)(ws + WS_TE); float* tg = (float*)(ws + WS_TG); int* tr = (int*)(ws + WS_TR); int* td = (int*)(ws + WS_TD);
    bf16_t* XS = (bf16_t*)(ws + WS_XS); bf16_t* YB = XS;
    (void)x; (void)in_sizes; (void)out_size;

    if (hipMemsetAsync(ctl, 0, CTL_BYTES, stream) != hipSuccess) return;
    MArgs a{};
    for (int i = 0; i < 18; ++i) a.in[i] = (const float*)d_in[i];
    a.out = out; a.ws = (unsigned char*)d_ws;
    a.ph_lo = 0; a.ph_hi = 10; a.li = 0;
    hipLaunchKernelGGL(mega, dim3(grid), dim3(NWAVES * 64), LDS_BYTES, stream, a);
}
```

```cpp
#include <hip/hip_runtime.h>
#include <stdint.h>
#include <cstdio>

typedef unsigned short bf16_t;
typedef short bf16x8 __attribute__((ext_vector_type(8)));
typedef float f32x4 __attribute__((ext_vector_type(4)));

constexpr int NTOK = 16384, DM = 1024, SEQ = 8192, INW = 3328;
constexpr int OQ = 0, OKK = 512, OV = 640, OP = 768, OGA = 1280, OGP = 2304;
constexpr int NE = 32, TOPK = 4, DE = 1024;
constexpr int MAXROWS = NTOK * TOPK + NE * 256;
constexpr int MAXTILES = MAXROWS / 256;
constexpr float ALPHA = 1.189207115002721f;
constexpr float LN_EPS = 1e-5f;

constexpr size_t WS_CTL = 0, CTL_BYTES = 262144;
constexpr size_t WS_U = CTL_BYTES;
constexpr size_t SZ_U = (size_t)NTOK * INW * 2;
constexpr size_t SZ_A16 = (size_t)NTOK * DM * 2;
constexpr size_t WS_AY = WS_U + SZ_U;
constexpr size_t WS_MIX = WS_AY + SZ_A16;
constexpr size_t WS_H1B = WS_MIX + SZ_A16;
constexpr size_t WS_XB = WS_H1B + SZ_A16;
constexpr size_t WS_Z = WS_XB + SZ_A16;
constexpr size_t WS_STAT = WS_Z + (size_t)NTOK * DM * 4;
constexpr size_t WS_TE = WS_STAT + (size_t)NTOK * 8;
constexpr size_t WS_TG = WS_TE + (size_t)NTOK * 16;
constexpr size_t WS_TR = WS_TG + (size_t)NTOK * 16;
constexpr size_t WS_TD = WS_TR + (size_t)NTOK * 16;
constexpr size_t WS_XS = WS_TD + (size_t)NTOK * 16;
constexpr size_t SZ_XS = (size_t)MAXROWS * DM * 2;
constexpr size_t WS_ACT = WS_XS + SZ_XS;
constexpr size_t WS_WIN = WS_ACT + SZ_XS;
constexpr size_t WS_WAB = WS_WIN + (size_t)INW * DM * 2;
constexpr size_t WS_WO = WS_WAB + (size_t)DM * DM * 2;
constexpr size_t WS_WG = WS_WO + (size_t)DM * DM * 2;
constexpr size_t WS_W1 = WS_WG + (size_t)4 * 128 * 128 * 2;
constexpr size_t WS_W2 = WS_W1 + (size_t)NE * 2 * DE * DM * 2;
constexpr size_t WS_WR = WS_W2 + (size_t)NE * DE * DM * 2;
constexpr size_t WS_RT = WS_WR + (size_t)NE * DM * 4 + 256;
constexpr size_t WS_X8 = WS_RT + (size_t)NE * NTOK * 4;
constexpr size_t WS_WIN8 = WS_X8 + (size_t)NTOK * DM;
constexpr size_t WS_END = WS_WIN8 + (size_t)INW * DM;
constexpr int CW_BAR = 4096;

__device__ __forceinline__ bf16_t f2bf(float f) { uint32_t u = __float_as_uint(f); u += 0x7fffu + ((u >> 16) & 1u); return (bf16_t)(u >> 16); }
__device__ __forceinline__ float bf2f(bf16_t b) { return __uint_as_float(((uint32_t)b) << 16); }
__device__ __forceinline__ float sigmoidf_(float x) { return 1.0f / (1.0f + __expf(-x)); }

template <int CTRL> __device__ __forceinline__ float dppf(float v) { return __builtin_bit_cast(float, __builtin_amdgcn_update_dpp(0, __builtin_bit_cast(int, v), CTRL, 0xf, 0xf, true)); }
template <int CTRL> __device__ __forceinline__ unsigned dppu(unsigned v) { return (unsigned)__builtin_amdgcn_update_dpp(0, (int)v, CTRL, 0xf, 0xf, true); }
__device__ __forceinline__ float wave_sum(float v) {
    v += dppf<0xB1>(v); v += dppf<0x4E>(v); v += dppf<0x141>(v); v += dppf<0x140>(v);
    const float s0 = __builtin_bit_cast(float, __builtin_amdgcn_readlane(__builtin_bit_cast(int, v), 0)), s1 = __builtin_bit_cast(float, __builtin_amdgcn_readlane(__builtin_bit_cast(int, v), 16));
    const float s2 = __builtin_bit_cast(float, __builtin_amdgcn_readlane(__builtin_bit_cast(int, v), 32)), s3 = __builtin_bit_cast(float, __builtin_amdgcn_readlane(__builtin_bit_cast(int, v), 48));
    return (s0 + s1) + (s2 + s3);
}
__device__ __forceinline__ unsigned max32u(unsigned k) {
    k = max(k, dppu<0xB1>(k)); k = max(k, dppu<0x4E>(k)); k = max(k, dppu<0x141>(k)); k = max(k, dppu<0x140>(k));
    const auto r = __builtin_amdgcn_permlane16_swap(k, k, false, false);
    return max(r[0], r[1]);
}
__device__ __forceinline__ float wave_max(float v) {
#pragma unroll
    for (int o = 1; o < 64; o <<= 1) v = fmaxf(v, __shfl_xor(v, o));
    return v;
}

#ifndef PROBE_T
#define PROBE_T -1
#endif
#ifndef PROBE_SKEW
#define PROBE_SKEW 0
#endif
#ifndef PROBE_PH
#define PROBE_PH -1
#endif
#define LAS __attribute__((address_space(3)))
typedef unsigned u32x4 __attribute__((ext_vector_type(4)));
typedef float f32x2 __attribute__((ext_vector_type(2)));
typedef unsigned u32x2 __attribute__((ext_vector_type(2)));
typedef int i32x8 __attribute__((ext_vector_type(8)));
constexpr float WSC = 32.0f, WSC_INV = 1.0f / 32.0f, MSC = 16.0f;
__device__ __forceinline__ unsigned pk4_fp8(float a, float b, float c, float d) { int w = __builtin_amdgcn_cvt_pk_fp8_f32(a, b, 0, false); w = __builtin_amdgcn_cvt_pk_fp8_f32(c, d, w, true); return (unsigned)w; }
typedef float f32x16 __attribute__((ext_vector_type(16)));
constexpr int NWAVES = 8;
constexpr int RING_BYTES = 131072;
constexpr int LDSX_OFF = RING_BYTES;
constexpr int LDS_BYTES = 147456;

typedef __bf16 bf16x2_t __attribute__((ext_vector_type(2)));
__device__ __forceinline__ unsigned cvt_pk_bf16(float lo, float hi) { f32x2 v = {lo, hi}; bf16x2_t b = __builtin_convertvector(v, bf16x2_t); return __builtin_bit_cast(unsigned, b); }
__device__ __forceinline__ float fast_sigmoid(float x) { return __builtin_amdgcn_rcpf(1.0f + __expf(-x)); }
__device__ __forceinline__ float bflo(unsigned w) { return __uint_as_float(w << 16); }
__device__ __forceinline__ float bfhi(unsigned w) { return __uint_as_float(w & 0xffff0000u); }

__device__ __forceinline__ int lane_id_here() { int l; asm volatile("v_mbcnt_lo_u32_b32 %0, -1, 0\n\tv_mbcnt_hi_u32_b32 %0, -1, %0" : "=v"(l)); return l; }
#define XB_TMO      128
#define XB_XCNT(j)  (256  + 64 * (j))
#define XB_XSUB(j)  (1280 + 64 * (j))
#define XB_XGEN(j)  (2304 + 64 * (j))
#define XB_TOP      3328
#define XB_TOPGEN   3392
#define XCD_BAR_WORDS 3456
#define XB_SPIN_CAP (1u << 18)
__device__ __forceinline__ unsigned xb_ld(unsigned* p)              { return __hip_atomic_load(p, __ATOMIC_RELAXED, __HIP_MEMORY_SCOPE_AGENT); }
__device__ __forceinline__ unsigned xb_add(unsigned* p, unsigned v) { return __hip_atomic_fetch_add(p, v, __ATOMIC_RELAXED, __HIP_MEMORY_SCOPE_AGENT); }
__device__ __forceinline__ unsigned xb_xcc_id() { return (unsigned)__builtin_amdgcn_s_getreg((3 << 11) | 20) & 0xFu; }
#define XB_SPIN(cond, bar) do { unsigned _sp = 0; while (cond) { __builtin_amdgcn_s_sleep(1); \
    if ((++_sp & 255u) == 0u) { if (xb_ld(&(bar)[XB_TMO])) break; if (_sp > XB_SPIN_CAP) { atomicAdd(&(bar)[XB_TMO], 1u); break; } } } } while (0)
struct XcdBarrier { unsigned* bar; unsigned x; volatile LAS unsigned* st; };
__device__ __forceinline__ bool xb_leader(int wave) { return wave == 0 && __builtin_amdgcn_mbcnt_hi(~0u, __builtin_amdgcn_mbcnt_lo(~0u, 0u)) == 0u; }
__device__ __forceinline__ XcdBarrier xcd_barrier_post(unsigned* bar, volatile LAS unsigned* st, int wave) {
    XcdBarrier b; b.bar = bar; b.x = xb_xcc_id(); b.st = st;
    if (xb_leader(wave)) (void)xb_add(&bar[XB_XCNT(b.x)], 1u);
    return b;
}
__device__ __forceinline__ void xcd_barrier_complete(unsigned* bar, unsigned x, unsigned& nloc, unsigned& nx) {
    const unsigned G = gridDim.x * gridDim.y * gridDim.z;
    unsigned sum, cnt, mine, sp = 0u;
    for (;;) {
        sum = 0u; cnt = 0u; mine = 0u;
#pragma unroll
        for (unsigned j = 0; j < 16; ++j) { const unsigned c = xb_ld(&bar[XB_XCNT(j)]); sum += c; cnt += (c > 0u) ? 1u : 0u; mine = (j == x) ? c : mine; }
        if (sum == G) break;
        __builtin_amdgcn_s_sleep(1);
        if ((++sp & 255u) == 0u) { if (xb_ld(&bar[XB_TMO])) break; if (sp > XB_SPIN_CAP) { atomicAdd(&bar[XB_TMO], 1u); break; } }
    }
    nloc = mine > 0u ? mine : 1u; nx = cnt > 0u ? cnt : 1u;
}
template <int NOFENCE = 0>
__device__ __forceinline__ void xcd_barrier(const XcdBarrier& b, int wave) {
    asm volatile("s_waitcnt vmcnt(0)" ::: "memory");
    __syncthreads();
    if (xb_leader(wave)) {
        unsigned* bar = b.bar;
        __builtin_amdgcn_s_waitcnt(0);
        unsigned nloc = b.st[0], nx = b.st[1];
        if (nloc == 0u) { xcd_barrier_complete(bar, b.x, nloc, nx); b.st[0] = nloc; b.st[1] = nx; }
        const unsigned old = xb_add(&bar[XB_XSUB(b.x)], 1u);
        const unsigned gen = old / nloc;
        if (old + 1u == (gen + 1u) * nloc) {
            if (!(NOFENCE & 1)) __builtin_amdgcn_fence(__ATOMIC_RELEASE, "agent");
            asm volatile("s_waitcnt vmcnt(0)" ::: "memory");
            (void)xb_add(&bar[XB_TOP], 1u);
        }
        const unsigned target = (gen + 1u) * nx;
        XB_SPIN((int)(xb_ld(&bar[XB_TOP]) - target) < 0, bar);
        if (!(NOFENCE & 2)) __builtin_amdgcn_fence(__ATOMIC_ACQUIRE, "agent");
        asm volatile("s_waitcnt vmcnt(0)" ::: "memory");
    }
    __syncthreads();
}

namespace pg8 {
constexpr int BM = 256, BK = 64, HALF = 128, HTB = HALF * BK * 2, STAGE_BYTES = 8 * HTB, NXCD = 8;
__host__ __device__ __forceinline__ int lds_byte(int r, int c) { const int st = (r >> 4) * 2 + (c >> 5), rr = r & 15, cc = c & 31, ob = rr * 64 + cc * 2; return st * 1024 + (ob ^ (((ob >> 9) & 1) << 5)); }
__host__ __device__ __forceinline__ void stage_rc(int b, int& R, int& C) { const int st = b / 1024, sb = b % 1024, swz = sb ^ (((sb >> 9) & 1) << 5); R = (st >> 1) * 16 + swz / 64; C = (st & 1) * 32 + (swz % 64) / 2; }
__host__ __device__ __forceinline__ int perm32(int rho) { const int n = rho >> 4, i = rho & 15; return 8 * (i >> 2) + 4 * n + (i & 3); }

struct Unit { int pm, pn, e, ord; };
struct Gemm { const bf16_t* A; const bf16_t* Bt; int K, lda, ldb; size_t bstrideE; };

struct StaticOrder {
    int nM, nN, nwg, G, c, wgm;
    __device__ __forceinline__ void init(int M, int N, int G_, int c_, int wgm_) { nM = M / BM; nN = N / BM; nwg = nM * nN; G = G_; c = c_; wgm = wgm_; }
    __device__ __forceinline__ bool next(int i, Unit& u) const {
        const int L = i * G + c; if (L >= nwg) return false;
        int wgid = (int)L; { const int q = nwg / NXCD, r = nwg % NXCD, xcd = wgid % NXCD, off = wgid / NXCD; wgid = (xcd < r ? xcd * (q + 1) : r * (q + 1) + (xcd - r) * q) + off; }
        const int nig = wgm * nN, gid = wgid / nig, fm = gid * wgm, gsz = (nM - fm) < wgm ? (nM - fm) : wgm;
        u.pm = fm + ((wgid % nig) % gsz); u.pn = (wgid % nig) / gsz; u.e = 0; u.ord = i; return true;
    }
};
struct P1OrderA { int c;
    __device__ __forceinline__ bool next(int i, Unit& u) const { if (i > 0 || c >= 128) return false; u.pm = c >> 1; u.pn = 3 + (c & 1); u.e = 0; u.ord = 0; return true; } };
struct P1OrderB { int c;
    __device__ __forceinline__ bool next(int i, Unit& u) const {
        int U;
        if (c < 128) { if (i >= 2) return false; U = c + 128 * i; }
        else if (c < 192) { if (i >= 4) return false; U = 256 + (c - 128) + 64 * i; }
        else { if (i >= 3) return false; U = 512 + (c - 192) + 64 * i; }
        const int t = U % 11; u.pm = U / 11; u.pn = t < 3 ? t : t + 2; u.e = 0; u.ord = i; return true; } };
struct MoeOrder {
    int nT, nN, nwg, G, c; const LAS int* tile_e;
    __device__ __forceinline__ bool next(int i, Unit& u) const {
        const int L = i * G + c; if (L >= nwg) return false;
        int wgid = (int)L; { const int q = nwg / NXCD, r = nwg % NXCD, xcd = wgid % NXCD, off = wgid / NXCD; wgid = (xcd < r ? xcd * (q + 1) : r * (q + 1) + (xcd - r) * q) + off; }
        const int nig = 4 * nN, gid = wgid / nig, fm = gid * 4, gsz = (nT - fm) < 4 ? (nT - fm) : 4;
        u.pm = fm + ((wgid % nig) % gsz); u.pn = (wgid % nig) / gsz; u.e = __builtin_amdgcn_readfirstlane(tile_e[u.pm]); u.ord = i; return true;
    }
};

typedef f32x4 Acc[2][2][4][2];
__device__ __forceinline__ i32x8 ld8x(const LAS unsigned char* p0, const LAS unsigned char* p1) { typedef int i32x4 __attribute__((ext_vector_type(4))); const i32x4 a = *(const LAS i32x4*)p0, b = *(const LAS i32x4*)p1; return __builtin_shufflevector(a, b, 0, 1, 2, 3, 4, 5, 6, 7); }
__device__ __forceinline__ i32x8 join8(bf16x8 lo, bf16x8 hi) { typedef int i32x4 __attribute__((ext_vector_type(4))); const i32x4 a = __builtin_bit_cast(i32x4, lo), b = __builtin_bit_cast(i32x4, hi); return __builtin_shufflevector(a, b, 0, 1, 2, 3, 4, 5, 6, 7); }

template <class Epi, class Sched, bool ALIGN_EPI, bool FP8 = false, bool GATHER = false>
__device__ __forceinline__ void gemm_phase(LAS unsigned char* lds, const Gemm g, const Sched& S, const Epi& E, int wid, const LAS unsigned short* rowlds = nullptr) {
    const int lane = (int)__builtin_amdgcn_mbcnt_hi(~0u, __builtin_amdgcn_mbcnt_lo(~0u, 0u)), tid = wid * 64 + lane, wr = wid >> 2, wc = wid & 3, fr = lane & 15, fq = lane >> 4;
    const int nt = g.K / BK;
    unsigned voffA, voffB; unsigned gRC;
    { int R, C; stage_rc(tid * 16, R, C); const int Rb = Epi::PERM ? ((R & ~31) + perm32(R & 31)) : R;
      voffA = (unsigned)(R * g.lda + C) * 2u; voffB = (unsigned)(Rb * g.ldb + C) * 2u; gRC = ((unsigned)R << 8) | ((unsigned)C * 2u); }
    const size_t kstep = (size_t)(BK * 2);
    const size_t hstepA = (size_t)HALF * g.lda * 2, hstepB = (size_t)HALF * g.ldb * 2;
    const size_t tstepA = 2 * hstepA, tstepB = 2 * hstepB;
    const size_t dlt_voffA = hstepA / 2, dlt_voffB = hstepB / 2;
    const unsigned ldsw = (unsigned)(uintptr_t)lds + (unsigned)wid * 1024u;
    const int aoff = FP8 ? (lds_byte(wr * 64 + fr, fq * 16) | ((fq & 1) << 4)) : lds_byte(wr * 64 + fr, fq * 8), boff = FP8 ? (lds_byte(wc * 32 + fr, fq * 16) | ((fq & 1) << 4)) : lds_byte(wc * 32 + fr, fq * 8);
#define PG8_SA(b, h) (((b) * 2 + (h)) * HTB)
#define PG8_SB(b, h) ((4 + (b) * 2 + (h)) * HTB)
#define PG8_STAGE(bufoff, gbase, voff) do { _Pragma("unroll") for (int _i = 0; _i < 2; ++_i) \
        asm volatile("s_mov_b32 m0, %0\n\ts_nop 0\n\tglobal_load_lds_dwordx4 %1, %2" :: "s"(ldsw + (unsigned)((bufoff) + _i * 8192)), "v"(voff), "s"((gbase) + _i * dlt_##voff) : "m0", "memory"); } while (0)
#define XSTA(bufoff, ptr, urow, h) do { if constexpr (GATHER) { _Pragma("unroll") for (int _i = 0; _i < 2; ++_i) { const unsigned vo_ = (unsigned)*(const LAS unsigned short*)((const LAS unsigned char*)rowlds + ((gRC >> 8) << 1) + (unsigned)__builtin_amdgcn_readfirstlane((urow) * 512 + (h) * 256 + _i * 128)) * (unsigned)DM + (gRC & 255u); \
        asm volatile("s_mov_b32 m0, %0\n\ts_nop 0\n\tglobal_load_lds_dwordx4 %1, %2" :: "s"(ldsw + (unsigned)((bufoff) + _i * 8192)), "v"(vo_), "s"(ptr) : "m0", "memory"); } } \
        else PG8_STAGE(bufoff, (ptr) + (h) * hstepA, voffA); } while (0)
#define PG8_LDA(dst, b, h) do { _Pragma("unroll") for (int m = 0; m < 4; ++m) _Pragma("unroll") for (int k = 0; k < 2; ++k) dst[m][k] = *(const LAS bf16x8*)(lds + PG8_SA(b, h) + aoff + m * 2048 + k * 1024); } while (0)
#define PG8_LDB(dst, b, h) do { _Pragma("unroll") for (int n = 0; n < 2; ++n) _Pragma("unroll") for (int k = 0; k < 2; ++k) dst[n][k] = *(const LAS bf16x8*)(lds + PG8_SB(b, h) + boff + n * 2048 + k * 1024); } while (0)
#define PG8_MMA16(ai, bj, At, Bt) do { __builtin_amdgcn_s_setprio(1); _Pragma("unroll") for (int m = 0; m < 4; ++m) _Pragma("unroll") for (int n = 0; n < 2; ++n) _Pragma("unroll") for (int k = 0; k < 2; ++k) \
        acc[ai][bj][m][n] = __builtin_amdgcn_mfma_f32_16x16x32_bf16(Bt[n][k], At[m][k], acc[ai][bj][m][n], 0, 0, 0); __builtin_amdgcn_s_setprio(0); } while (0)
#define PG8_LDA8(dst, b, h) do { _Pragma("unroll") for (int m = 0; m < 4; ++m) dst[m] = ld8x(lds + PG8_SA(b, h) + aoff + m * 2048, lds + PG8_SA(b, h) + (aoff ^ 16) + m * 2048); } while (0)
#define PG8_LDB8(dst, b, h) do { _Pragma("unroll") for (int n = 0; n < 2; ++n) dst[n] = ld8x(lds + PG8_SB(b, h) + boff + n * 2048, lds + PG8_SB(b, h) + (boff ^ 16) + n * 2048); } while (0)
#define PG8_MMA8(ai, bj, At, Bt) do { __builtin_amdgcn_s_setprio(1); _Pragma("unroll") for (int m = 0; m < 4; ++m) _Pragma("unroll") for (int n = 0; n < 2; ++n) \
        acc[ai][bj][m][n] = __builtin_amdgcn_mfma_scale_f32_16x16x128_f8f6f4(Bt[n], At[m], acc[ai][bj][m][n], 0, 0, 0, 0, 0, 0); __builtin_amdgcn_s_setprio(0); } while (0)
#define PG8_WAIT_V(n) asm volatile("s_waitcnt vmcnt(" #n ")" ::: "memory")
#define PG8_WAIT_L(n) asm volatile("s_waitcnt lgkmcnt(" #n ")" ::: "memory")
#define PG8_BAR __builtin_amdgcn_s_barrier()
#define PG8_SCHED __builtin_amdgcn_sched_barrier(0)
    Unit cur, nxt; int ui = 0;
    if (!S.next(0, cur)) return;
    Acc acc;
#pragma unroll
    for (int a = 0; a < 2; ++a)
#pragma unroll
        for (int b = 0; b < 2; ++b)
#pragma unroll
            for (int m = 0; m < 4; ++m)
#pragma unroll
                for (int n = 0; n < 2; ++n) acc[a][b][m][n] = (f32x4){0.f, 0.f, 0.f, 0.f};
    bf16x8 At[FP8 ? 1 : 4][2], B0[FP8 ? 1 : 2][2], B1[FP8 ? 1 : 2][2]; i32x8 At8[FP8 ? 4 : 1], B08[FP8 ? 2 : 1], B18[FP8 ? 2 : 1];
#define XLDA(b, h) do { if constexpr (FP8) PG8_LDA8(At8, b, h); else PG8_LDA(At, b, h); } while (0)
#define XLDB0(b, h) do { if constexpr (FP8) PG8_LDB8(B08, b, h); else PG8_LDB(B0, b, h); } while (0)
#define XLDB1(b, h) do { if constexpr (FP8) PG8_LDB8(B18, b, h); else PG8_LDB(B1, b, h); } while (0)
#define XMMA0(ai, bj) do { if constexpr (FP8) PG8_MMA8(ai, bj, At8, B08); else PG8_MMA16(ai, bj, At, B0); } while (0)
#define XMMA1(ai, bj) do { if constexpr (FP8) PG8_MMA8(ai, bj, At8, B18); else PG8_MMA16(ai, bj, At, B1); } while (0)
    const char* cA = (const char*)g.A + (GATHER ? (size_t)0 : (size_t)cur.pm * tstepA); const char* cB = (const char*)g.Bt + (size_t)cur.e * g.bstrideE + (size_t)cur.pn * tstepB;
    PG8_STAGE(PG8_SB(0, 0), cB, voffB); PG8_STAGE(PG8_SB(0, 1), cB + hstepB, voffB); XSTA(PG8_SA(0, 0), cA, 0, 0); XSTA(PG8_SA(0, 1), cA, 0, 1);
    if (wr == 1) PG8_BAR;
    PG8_WAIT_V(2); PG8_BAR;
    PG8_STAGE(PG8_SB(1, 0), cB + kstep, voffB); XSTA(PG8_SA(1, 0), cA + kstep, 0, 0); PG8_STAGE(PG8_SB(1, 1), cB + hstepB + kstep, voffB);
    PG8_WAIT_V(6); PG8_BAR;
    for (;;) {
        const bool has_next = S.next(ui + 1, nxt);
        const char* nA = (has_next && !GATHER) ? (const char*)g.A + (size_t)nxt.pm * tstepA : cA;
        const char* nB = has_next ? (const char*)g.Bt + (size_t)nxt.e * g.bstrideE + (size_t)nxt.pn * tstepB : cB;
#define PG8_KBODY(t) do { \
            const bool last = (t == nt - 2); const int u2 = (last && has_next) ? ui + 1 : ui; \
            const char* a1 = cA + (size_t)(t + 1) * kstep; \
            const char* a2 = last ? (GATHER ? (const char*)g.A : nA) : cA + (size_t)(t + 2) * kstep; const char* b2 = last ? nB : cB + (size_t)(t + 2) * kstep; \
            const char* a3 = a2 + kstep; const char* b3 = b2 + kstep; \
            XSTA(PG8_SA(1, 1), a1, ui, 1); XLDB0(0, 0); XLDB1(0, 1); PG8_SCHED; XLDA(0, 0); \
            PG8_WAIT_V(8); PG8_WAIT_L(0); PG8_BAR; XMMA0(0, 0); XMMA1(0, 1); PG8_BAR; PG8_SCHED; \
            PG8_STAGE(PG8_SB(0, 0), b2, voffB); PG8_STAGE(PG8_SB(0, 1), b2 + hstepB, voffB); XSTA(PG8_SA(0, 0), a2, u2, 0); XLDA(0, 1); \
            PG8_WAIT_V(8); PG8_WAIT_L(0); PG8_BAR; XMMA0(1, 0); XMMA1(1, 1); PG8_BAR; PG8_SCHED; \
            XSTA(PG8_SA(0, 1), a2, u2, 1); XLDB0(1, 0); XLDB1(1, 1); PG8_SCHED; XLDA(1, 0); \
            PG8_WAIT_V(8); PG8_WAIT_L(0); PG8_BAR; XMMA0(0, 0); XMMA1(0, 1); PG8_BAR; PG8_SCHED; \
            PG8_STAGE(PG8_SB(1, 0), b3, voffB); PG8_STAGE(PG8_SB(1, 1), b3 + hstepB, voffB); XSTA(PG8_SA(1, 0), a3, u2, 0); XLDA(1, 1); \
            PG8_WAIT_V(8); PG8_WAIT_L(0); PG8_BAR; XMMA0(1, 0); XMMA1(1, 1); PG8_BAR; PG8_SCHED; \
        } while (0)
        if constexpr (Epi::HAS_MID) {
#pragma nounroll
            for (int t = 0; t < Epi::MID_T; t += 2) PG8_KBODY(t);
            E.mid(acc, cur, wr, wc, fr, fq);
#pragma nounroll
            for (int t = Epi::MID_T; t < nt; t += 2) PG8_KBODY(t);
        } else {
#pragma nounroll
            for (int t = 0; t < nt; t += 2) PG8_KBODY(t);
        }
        if constexpr (ALIGN_EPI) { if (wr == 0) PG8_BAR; }
        {
            const int l2 = lane_id_here();
            E(acc, cur, wid >> 2, wid & 3, l2 & 15, l2 >> 4);
        }
        if (!has_next) break;
#pragma unroll
        for (int a = 0; a < 2; ++a)
#pragma unroll
            for (int b = 0; b < 2; ++b)
#pragma unroll
                for (int m = 0; m < 4; ++m)
#pragma unroll
                    for (int n = 0; n < 2; ++n) acc[a][b][m][n] = (f32x4){0.f, 0.f, 0.f, 0.f};
        cur = nxt; cA = nA; cB = nB; ++ui;
        if constexpr (ALIGN_EPI) { if (wr == 1) PG8_BAR; }
    }
    PG8_WAIT_V(0);
    if constexpr (!ALIGN_EPI) { if (wr == 0) PG8_BAR; }
    PG8_BAR;
#undef PG8_SA
#undef PG8_SB
#undef PG8_STAGE
#undef PG8_KBODY
#undef XSTA
#undef PG8_LDA
#undef PG8_LDB
#undef PG8_MMA16
#undef PG8_MMA8
#undef PG8_LDA8
#undef PG8_LDB8
#undef XLDA
#undef XLDB0
#undef XLDB1
#undef XMMA0
#undef XMMA1
#undef PG8_WAIT_V
#undef PG8_WAIT_L
#undef PG8_BAR
#undef PG8_SCHED
}

__device__ __forceinline__ u32x4 pack8(const f32x4 v0, const f32x4 v1) { u32x4 w; w.x = cvt_pk_bf16(v0[0], v0[1]); w.y = cvt_pk_bf16(v0[2], v0[3]); w.z = cvt_pk_bf16(v1[0], v1[1]); w.w = cvt_pk_bf16(v1[2], v1[3]); return w; }
__device__ __forceinline__ void unpack8(const u32x4 w, f32x4& v0, f32x4& v1) { v0 = (f32x4){bflo(w.x), bfhi(w.x), bflo(w.y), bfhi(w.y)}; v1 = (f32x4){bflo(w.z), bfhi(w.z), bflo(w.w), bfhi(w.w)}; }

struct EpiU { static constexpr bool HAS_MID = false; static constexpr bool PERM = true; bf16_t* U; float sc;
    __device__ __forceinline__ void operator()(const Acc& acc, const Unit& u, int wr, int wc, int fr, int fq) const {
        const int row0 = u.pm * BM + wr * 64 + fr, col0 = u.pn * BM + wc * 32 + 8 * fq;
        const int mode = u.pn < 2 ? 1 : (u.pn >= 5 ? 2 : 0);
        const float s1 = mode == 1 ? 0.125f * sc : sc;
#pragma unroll
        for (int ai = 0; ai < 2; ++ai)
#pragma unroll
            for (int m = 0; m < 4; ++m) { bf16_t* rowp = U + (size_t)(row0 + ai * HALF + m * 16) * INW + col0;
#pragma unroll
                for (int bj = 0; bj < 2; ++bj) { f32x4 v0 = acc[ai][bj][m][0] * s1, v1 = acc[ai][bj][m][1] * s1;
                    if (mode == 2) {
#pragma unroll
                        for (int j = 0; j < 4; ++j) { v0[j] = fast_sigmoid(v0[j]); v1[j] = fast_sigmoid(v1[j]); } }
                    *(u32x4*)(rowp + bj * HALF) = pack8(v0, v1); } }
    } };
struct EpiBrA { static constexpr bool HAS_MID = false; static constexpr bool PERM = true; const bf16_t* U; float* T;
    __device__ __forceinline__ void operator()(const Acc& acc, const Unit& u, int wr, int wc, int fr, int fq) const {
        const int row0 = u.pm * BM + wr * 64 + fr, col0 = u.pn * BM + wc * 32 + 8 * fq;
#pragma unroll
        for (int ai = 0; ai < 2; ++ai)
#pragma unroll
            for (int m = 0; m < 4; ++m) { const size_t row = (size_t)(row0 + ai * HALF + m * 16);
#pragma unroll
                for (int bj = 0; bj < 2; ++bj) { const int col = col0 + bj * HALF; f32x4 g0, g1; unpack8(*(const u32x4*)(U + row * INW + OGA + col), g0, g1);
                    float* tp = T + row * DM + col; *(f32x4*)tp = g0 * acc[ai][bj][m][0]; *(f32x4*)(tp + 4) = g1 * acc[ai][bj][m][1]; } }
    } };
struct EpiBrP { static constexpr bool HAS_MID = false; static constexpr bool PERM = true; const bf16_t* U; const float* T; bf16_t* MIX;
    __device__ __forceinline__ void operator()(const Acc& acc, const Unit& u, int wr, int wc, int fr, int fq) const {
        const int row0 = u.pm * BM + wr * 64 + fr, col0 = u.pn * BM + wc * 32 + 8 * fq;
#pragma unroll
        for (int ai = 0; ai < 2; ++ai)
#pragma unroll
            for (int m = 0; m < 4; ++m) { const size_t row = (size_t)(row0 + ai * HALF + m * 16);
#pragma unroll
                for (int bj = 0; bj < 2; ++bj) { const int col = col0 + bj * HALF; f32x4 g0, g1; unpack8(*(const u32x4*)(U + row * INW + OGP + col), g0, g1);
                    const float* tp = T + row * DM + col; const f32x4 t0 = *(const f32x4*)tp, t1 = *(const f32x4*)(tp + 4);
                    *(u32x4*)(MIX + row * DM + col) = pack8(t0 + g0 * acc[ai][bj][m][0], t1 + g1 * acc[ai][bj][m][1]); } }
    } };
struct EpiMix { static constexpr bool HAS_MID = true; static constexpr int MID_T = 8; static constexpr bool PERM = true; const bf16_t* U; bf16_t* MIX;
    __device__ __forceinline__ void mid(Acc& acc, const Unit& u, int wr, int wc, int fr, int fq) const {
        const int row0 = u.pm * BM + wr * 64 + fr, col0 = u.pn * BM + wc * 32 + 8 * fq;
#pragma unroll
        for (int ai = 0; ai < 2; ++ai)
#pragma unroll
            for (int m = 0; m < 4; ++m) { const bf16_t* up = U + (size_t)(row0 + ai * HALF + m * 16) * INW + col0;
#pragma unroll
                for (int bj = 0; bj < 2; ++bj) { f32x4 a0, a1, p0, p1; unpack8(*(const u32x4*)(up + OGA + bj * HALF), a0, a1); unpack8(*(const u32x4*)(up + OGP + bj * HALF), p0, p1);
#pragma unroll
                    for (int j = 0; j < 4; ++j) { acc[ai][bj][m][0][j] *= a0[j] * __builtin_amdgcn_rcpf(fmaxf(p0[j], 1e-20f)); acc[ai][bj][m][1][j] *= a1[j] * __builtin_amdgcn_rcpf(fmaxf(p1[j], 1e-20f)); } } }
    }
    __device__ __forceinline__ void operator()(const Acc& acc, const Unit& u, int wr, int wc, int fr, int fq) const {
        const int row0 = u.pm * BM + wr * 64 + fr, col0 = u.pn * BM + wc * 32 + 8 * fq;
#pragma unroll
        for (int ai = 0; ai < 2; ++ai)
#pragma unroll
            for (int m = 0; m < 4; ++m) { const size_t row = (size_t)(row0 + ai * HALF + m * 16);
#pragma unroll
                for (int bj = 0; bj < 2; ++bj) { const int col = col0 + bj * HALF; f32x4 p0, p1; unpack8(*(const u32x4*)(U + row * INW + OGP + col), p0, p1);
#pragma unroll
                    for (int j = 0; j < 4; ++j) { p0[j] = fmaxf(p0[j], 1e-20f); p1[j] = fmaxf(p1[j], 1e-20f); }
                    const f32x4 m0 = p0 * acc[ai][bj][m][0] * MSC, m1 = p1 * acc[ai][bj][m][1] * MSC; u32x2 o; o.x = pk4_fp8(m0[0], m0[1], m0[2], m0[3]); o.y = pk4_fp8(m1[0], m1[1], m1[2], m1[3]);
                    *(u32x2*)((unsigned char*)MIX + row * DM + col) = o; } }
    } };
struct EpiZ { static constexpr bool HAS_MID = false; static constexpr bool PERM = true; const bf16_t* XB; bf16_t* Z; float sc;
    __device__ __forceinline__ void operator()(const Acc& acc, const Unit& u, int wr, int wc, int fr, int fq) const {
        const int row0 = u.pm * BM + wr * 64 + fr, col0 = u.pn * BM + wc * 32 + 8 * fq;
#pragma unroll
        for (int ai = 0; ai < 2; ++ai)
#pragma unroll
            for (int m = 0; m < 4; ++m) { const size_t off = (size_t)(row0 + ai * HALF + m * 16) * DM + col0;
#pragma unroll
                for (int bj = 0; bj < 2; ++bj) { f32x4 x0, x1; unpack8(*(const u32x4*)(XB + off + bj * HALF), x0, x1);
                    *(u32x4*)(Z + off + bj * HALF) = pack8(x0 * ALPHA + acc[ai][bj][m][0] * sc, x1 * ALPHA + acc[ai][bj][m][1] * sc); } }
    } };
struct EpiAct { static constexpr bool HAS_MID = false; static constexpr bool PERM = true; const LAS bf16_t* bl; unsigned char* ACT;
    __device__ __forceinline__ void operator()(const Acc& acc, const Unit& u, int wr, int wc, int fr, int fq) const {
        const int row0 = u.pm * BM + wr * 64 + fr, j0 = u.pn * HALF + wc * 32 + 8 * fq;
        const LAS bf16_t* bp = bl + u.ord * 256 + wc * 32 + 8 * fq;
        f32x4 bg0, bg1, bu0, bu1; unpack8(*(const LAS u32x4*)bp, bg0, bg1); unpack8(*(const LAS u32x4*)(bp + 128), bu0, bu1);
#pragma unroll
        for (int ai = 0; ai < 2; ++ai)
#pragma unroll
            for (int m = 0; m < 4; ++m) {
                f32x4 o[2];
#pragma unroll
                for (int n = 0; n < 2; ++n) { const f32x4 hg = acc[ai][0][m][n] * WSC_INV + (n ? bg1 : bg0), hu = acc[ai][1][m][n] * WSC_INV + (n ? bu1 : bu0);
#pragma unroll
                    for (int j = 0; j < 4; ++j) { const float gate = fminf(hg[j], 7.0f), up = fminf(fmaxf(hu[j], -7.0f), 7.0f); o[n][j] = (up + 1.0f) * gate * fast_sigmoid(1.702f * gate); } }
                u32x2 w8; w8.x = pk4_fp8(o[0][0], o[0][1], o[0][2], o[0][3]); w8.y = pk4_fp8(o[1][0], o[1][1], o[1][2], o[1][3]);
                *(u32x2*)(ACT + (size_t)(row0 + ai * HALF + m * 16) * DE + j0) = w8; }
    } };
struct EpiY { static constexpr bool HAS_MID = false; static constexpr bool PERM = true; const LAS float* bl; bf16_t* YB;
    __device__ __forceinline__ void operator()(const Acc& acc, const Unit& u, int wr, int wc, int fr, int fq) const {
        const int row0 = u.pm * BM + wr * 64 + fr, col0 = u.pn * BM + wc * 32 + 8 * fq;
        const LAS float* bp = bl + u.ord * 256 + wc * 32 + 8 * fq;
        f32x4 bv[2][2];
#pragma unroll
        for (int bj = 0; bj < 2; ++bj) { bv[bj][0] = *(const LAS f32x4*)(bp + bj * HALF); bv[bj][1] = *(const LAS f32x4*)(bp + bj * HALF + 4); }
#pragma unroll
        for (int ai = 0; ai < 2; ++ai)
#pragma unroll
            for (int m = 0; m < 4; ++m) { bf16_t* rowp = YB + (size_t)(row0 + ai * HALF + m * 16) * DM + col0;
#pragma unroll
                for (int bj = 0; bj < 2; ++bj) *(u32x4*)(rowp + bj * HALF) = pack8(acc[ai][bj][m][0] * WSC_INV + bv[bj][0], acc[ai][bj][m][1] * WSC_INV + bv[bj][1]); }
    } };
}

template <bool NT, bool F8 = false>
__device__ __forceinline__ void p0_item(const float* W, int N, int k0, int n0, bf16_t* WT, int ldt, int drow0, int dk0, LAS float* scr, int lane) {
    const int kr = lane >> 3, n4 = (lane & 7) * 4;
    f32x4 v[8];
#pragma unroll
    for (int i = 0; i < 8; ++i) { const f32x4* p = (const f32x4*)(W + (size_t)(k0 + 8 * i + kr) * N + n0 + n4); v[i] = NT ? __builtin_nontemporal_load(p) : *p; }
#pragma unroll
    for (int i = 0; i < 8; ++i) { LAS float* d = scr + (8 * i + kr) * 33 + n4; d[0] = v[i][0]; d[1] = v[i][1]; d[2] = v[i][2]; d[3] = v[i][3]; }
    asm volatile("s_waitcnt lgkmcnt(0)" ::: "memory");
    const int c = lane & 7;
#pragma unroll
    for (int j = 0; j < 4; ++j) { const int n = (lane >> 3) + 8 * j; const LAS float* s = scr + (8 * c) * 33 + n;
        if constexpr (F8) { u32x2 o; o.x = pk4_fp8(s[0 * 33] * WSC, s[1 * 33] * WSC, s[2 * 33] * WSC, s[3 * 33] * WSC); o.y = pk4_fp8(s[4 * 33] * WSC, s[5 * 33] * WSC, s[6 * 33] * WSC, s[7 * 33] * WSC);
            *(u32x2*)((unsigned char*)WT + (size_t)(drow0 + n) * ldt + dk0 + k0 + 8 * c) = o; }
        else { u32x4 o; o.x = cvt_pk_bf16(s[0 * 33], s[1 * 33]); o.y = cvt_pk_bf16(s[2 * 33], s[3 * 33]); o.z = cvt_pk_bf16(s[4 * 33], s[5 * 33]); o.w = cvt_pk_bf16(s[6 * 33], s[7 * 33]);
            *(u32x4*)(WT + (size_t)(drow0 + n) * ldt + dk0 + k0 + 8 * c) = o; } }
    asm volatile("s_waitcnt lgkmcnt(0)" ::: "memory");
}
constexpr int W1_Q1 = 11264;
constexpr int CONV_I1 = NE * (DM / 64) * (2 * DE / 32), CONV_I2 = NE * (DE / 64) * (DM / 32);
struct ConvItem { const float* W; unsigned char* WT; int N, ldt, k0, n0, drow; };
__device__ __forceinline__ void conv_load(f32x4 (&v)[8], const ConvItem& it, int lane) {
    const int kr = lane >> 3, n4 = (lane & 7) * 4;
#pragma unroll
    for (int i = 0; i < 8; ++i) v[i] = __builtin_nontemporal_load((const f32x4*)(it.W + (size_t)(it.k0 + 8 * i + kr) * it.N + it.n0 + n4));
}
__device__ __forceinline__ void conv_finish(const f32x4 (&v)[8], const ConvItem& it, LAS float* scr, int lane) {
    const int kr = lane >> 3, n4 = (lane & 7) * 4;
#pragma unroll
    for (int i = 0; i < 8; ++i) { LAS float* d = scr + (8 * i + kr) * 33 + n4; d[0] = v[i][0]; d[1] = v[i][1]; d[2] = v[i][2]; d[3] = v[i][3]; }
    asm volatile("s_waitcnt lgkmcnt(0)" ::: "memory");
    const int c = lane & 7;
#pragma unroll
    for (int j = 0; j < 4; ++j) { const int n = (lane >> 3) + 8 * j; const LAS float* sp = scr + (8 * c) * 33 + n;
        u32x2 o; o.x = pk4_fp8(sp[0 * 33] * WSC, sp[1 * 33] * WSC, sp[2 * 33] * WSC, sp[3 * 33] * WSC); o.y = pk4_fp8(sp[4 * 33] * WSC, sp[5 * 33] * WSC, sp[6 * 33] * WSC, sp[7 * 33] * WSC);
        *(u32x2*)(it.WT + (size_t)(it.drow + n) * it.ldt + it.k0 + 8 * c) = o; }
    asm volatile("s_waitcnt lgkmcnt(0)" ::: "memory");
}
__device__ __forceinline__ ConvItem w1_item(const float* w1, bf16_t* W1t, int r) {
    constexpr int I_1 = (DM / 64) * (2 * DE / 32), KB = DM / 64;
    const int e = r / I_1, q = r % I_1, n0 = 32 * (q / KB), k0 = 64 * (q % KB);
    const int drow = n0 < DE ? 256 * (n0 >> 7) + (n0 & 127) : 256 * ((n0 - DE) >> 7) + 128 + ((n0 - DE) & 127);
    return ConvItem{w1 + (size_t)e * DM * 2 * DE, (unsigned char*)W1t + (size_t)e * 2 * DE * DM, 2 * DE, DM, k0, n0, drow};
}
__device__ __forceinline__ ConvItem w2_item(const float* w2, bf16_t* W2t, int r) {
    constexpr int I_2 = (DE / 64) * (DM / 32), KB = DE / 64;
    const int e = r / I_2, q = r % I_2, n0 = 32 * (q / KB), k0 = 64 * (q % KB);
    return ConvItem{w2 + (size_t)e * DE * DM, (unsigned char*)W2t + (size_t)e * DM * DE, DM, DE, k0, n0, n0};
}
template <int WHICH>
__device__ __forceinline__ void conv_w(const float* w, bf16_t* Wt, LAS float* scr, int first, int last, int worker, int nworkers, int lane) {
    int p = (first >> 1) + worker; const int pe = last >> 1;
    if (p >= pe) return;
    f32x4 r0[8], r1[8];
    ConvItem i0 = WHICH == 1 ? w1_item(w, Wt, 2 * p) : w2_item(w, Wt, 2 * p), i1 = WHICH == 1 ? w1_item(w, Wt, 2 * p + 1) : w2_item(w, Wt, 2 * p + 1);
    conv_load(r0, i0, lane); conv_load(r1, i1, lane);
    for (;;) {
        const int pn = p + nworkers; const bool more = pn < pe;
        conv_finish(r0, i0, scr, lane);
        if (more) { i0 = WHICH == 1 ? w1_item(w, Wt, 2 * pn) : w2_item(w, Wt, 2 * pn); conv_load(r0, i0, lane); }
        conv_finish(r1, i1, scr, lane);
        if (!more) break;
        i1 = WHICH == 1 ? w1_item(w, Wt, 2 * pn + 1) : w2_item(w, Wt, 2 * pn + 1); conv_load(r1, i1, lane);
        p = pn;
    }
}
__device__ __forceinline__ void conv_w1(const float* w1, bf16_t* W1t, LAS float* scr, int first, int last, int worker, int nworkers, int lane) { conv_w<1>(w1, W1t, scr, first, last, worker, nworkers, lane); }
__device__ __forceinline__ void conv_w2(const float* w2, bf16_t* W2t, LAS float* scr, int first, int last, int worker, int nworkers, int lane) { conv_w<2>(w2, W2t, scr, first, last, worker, nworkers, lane); }

constexpr int PL_STRIDE = 272, PL_YS_OFF = 144 * PL_STRIDE, PL_WS_OFF = PL_YS_OFF + 128 * PL_STRIDE;
struct PoolRegs { u32x4 p[5]; u32x4 w[4]; };
__device__ __forceinline__ void pool_fetch(PoolRegs& pr, const bf16_t* __restrict__ U, const bf16_t* __restrict__ Wgt, int unit, int tid) {
    const int g = unit & 3, tt = unit >> 2, tok0 = tt * 128, b = tok0 / SEQ, t0 = tok0 % SEQ;
#pragma unroll
    for (int j = 0; j < 5; ++j) { const int p = tid + 512 * j, lr = p >> 4, c8 = p & 15, t = t0 - 8 + lr; pr.p[j] = (u32x4){0u, 0u, 0u, 0u};
        if (p < 144 * 16 && t >= 0 && t < SEQ) pr.p[j] = *(const u32x4*)(U + (size_t)(b * SEQ + t) * INW + OP + 128 * g + 8 * c8); }
#pragma unroll
    for (int j = 0; j < 4; ++j) { const int p = tid + 512 * j, r = p >> 4, c8 = p & 15; pr.w[j] = *(const u32x4*)(Wgt + (size_t)(g * 128 + r) * 128 + 8 * c8); }
}
__device__ __forceinline__ void pool_put(const PoolRegs& pr, LAS unsigned char* lds, int tid) {
    LAS unsigned char* Ps = lds; LAS unsigned char* Ws = lds + PL_WS_OFF;
#pragma unroll
    for (int j = 0; j < 5; ++j) { const int p = tid + 512 * j, lr = p >> 4, c8 = p & 15; if (p < 144 * 16) *(LAS u32x4*)(Ps + lr * PL_STRIDE + c8 * 16) = pr.p[j]; }
#pragma unroll
    for (int j = 0; j < 4; ++j) { const int p = tid + 512 * j, r = p >> 4, c8 = p & 15; *(LAS u32x4*)(Ws + r * PL_STRIDE + c8 * 16) = pr.w[j]; }
}
__device__ __forceinline__ int crow(int r, int hi) { return (r & 3) + 8 * (r >> 2) + 4 * hi; }
constexpr int KS_STRIDE = 144, VT_STRIDE = 776, ATT_VT_OFF = 384 * KS_STRIDE, ATT_SC_OFF = ATT_VT_OFF + 64 * VT_STRIDE;
template <bool PF>
__device__ __forceinline__ void attn_unit(LAS unsigned char* lds, const bf16_t* __restrict__ U, const float* __restrict__ sinks, bf16_t* __restrict__ AY, int unit, int tid, int wave, int lane, PoolRegs& pr, const bf16_t* __restrict__ Wgt, int next_pool) {
    const int kvh = unit & 1, blk = (unit >> 1) & 63, b = unit >> 7;
    const int tok0 = b * SEQ + blk * 128;
    LAS unsigned char* Ks = lds; LAS unsigned char* Vt = lds + ATT_VT_OFF; LAS float* lsc = (LAS float*)(lds + ATT_SC_OFF) + wave * 64;
    const int g = wave >> 1, qh = wave & 1, h = 4 * kvh + g, l31 = lane & 31, hh = lane >> 5;
    const float slope = exp2f(-(float)(h + 1)), sink = sinks[h];
    bf16x8 qf[2][4];
#pragma unroll
    for (int qb = 0; qb < 2; ++qb)
#pragma unroll
        for (int s4 = 0; s4 < 4; ++s4) qf[qb][s4] = *(const bf16x8*)(U + (size_t)(tok0 + 64 * qh + 32 * qb + l31) * INW + OQ + h * 64 + 16 * s4 + 8 * hh);
    float kn2 = 0.f;
    for (int p = tid; p < 3072; p += 512) {
        const int row = p >> 3, c8 = p & 7, kb = blk - 1 + (row >> 7); u32x4 v = (u32x4){0u, 0u, 0u, 0u};
        if (kb >= 0 && kb < SEQ / 128) v = *(const u32x4*)(U + (size_t)(b * SEQ + kb * 128 + (row & 127)) * INW + OKK + kvh * 64 + 8 * c8);
        *(LAS u32x4*)(Ks + row * KS_STRIDE + c8 * 16) = v;
        f32x4 k0, k1; pg8::unpack8(v, k0, k1);
        float ss = (k0[0] * k0[0] + k0[1] * k0[1]) + (k0[2] * k0[2] + k0[3] * k0[3]) + (k1[0] * k1[0] + k1[1] * k1[1]) + (k1[2] * k1[2] + k1[3] * k1[3]);
        ss += dppf<0xB1>(ss); ss += dppf<0x4E>(ss); ss += dppf<0x141>(ss);
        kn2 = fmaxf(kn2, ss);
    }
    kn2 = fmaxf(kn2, __shfl_xor(kn2, 8)); kn2 = fmaxf(kn2, __shfl_xor(kn2, 16)); kn2 = fmaxf(kn2, __shfl_xor(kn2, 32));
    LAS float* knw = (LAS float*)(lds + ATT_SC_OFF + 2048);
    if (lane == 0) knw[wave] = kn2;
    for (int pp = tid; pp < 1536; pp += 512) {
        const int kp = pp >> 3, dc = pp & 7, row = 2 * kp, kb = blk - 1 + (row >> 7); u32x4 v0 = (u32x4){0u, 0u, 0u, 0u}, v1 = v0;
        if (kb >= 0 && kb < SEQ / 128) { const bf16_t* src = U + (size_t)(b * SEQ + kb * 128 + (row & 127)) * INW + OV + kvh * 64 + 8 * dc; v0 = *(const u32x4*)src; v1 = *(const u32x4*)(src + INW); }
        LAS unsigned char* dst = Vt + (8 * dc) * VT_STRIDE + kp * 4;
#pragma unroll
        for (int i = 0; i < 4; ++i) {
            const unsigned w0 = v0[i], w1 = v1[i];
            *(LAS unsigned*)(dst + (2 * i) * VT_STRIDE) = (w0 & 0xffffu) | (w1 << 16);
            *(LAS unsigned*)(dst + (2 * i + 1) * VT_STRIDE) = (w0 >> 16) | (w1 & 0xffff0000u);
        }
    }
    __syncthreads();
    const int kt0 = max(qh ? 2 : 0, blk == 0 ? 4 : 0), kt1 = min(qh ? 12 : 10, blk == SEQ / 128 - 1 ? 8 : 12);
    const float nslope = -slope;
    float mx[2];
    { const float kmax2 = fmaxf(fmaxf(fmaxf(knw[0], knw[1]), fmaxf(knw[2], knw[3])), fmaxf(fmaxf(knw[4], knw[5]), fmaxf(knw[6], knw[7])));
#pragma unroll
      for (int qb = 0; qb < 2; ++qb) { float qs = 0.f;
#pragma unroll
          for (int s4 = 0; s4 < 4; ++s4) { f32x4 q0, q1; pg8::unpack8(__builtin_bit_cast(u32x4, qf[qb][s4]), q0, q1);
              qs += (q0[0] * q0[0] + q0[1] * q0[1]) + (q0[2] * q0[2] + q0[3] * q0[3]) + (q1[0] * q1[0] + q1[1] * q1[1]) + (q1[2] * q1[2] + q1[3] * q1[3]); }
          qs += __shfl_xor(qs, 32);
          mx[qb] = fmaxf(sink, sqrtf(qs * kmax2)); } }
    const float L2E = 1.4426950408889634f;
    float lsum[2] = {0.f, 0.f};
    f32x16 o[2][2];
#pragma unroll
    for (int qb = 0; qb < 2; ++qb)
#pragma unroll
        for (int db = 0; db < 2; ++db)
#pragma unroll
            for (int r = 0; r < 16; ++r) o[qb][db][r] = 0.f;
    for (int kt = kt0; kt < kt1; ++kt) {
        bf16x8 kf[4];
#pragma unroll
        for (int s4 = 0; s4 < 4; ++s4) kf[s4] = *(const LAS bf16x8*)(Ks + (kt * 32 + l31) * KS_STRIDE + (16 * s4 + 8 * hh) * 2);
        bf16x8 vf[2][2];
#pragma unroll
        for (int db = 0; db < 2; ++db)
#pragma unroll
            for (int s2 = 0; s2 < 2; ++s2) {
                const LAS unsigned char* vp = Vt + (32 * db + l31) * VT_STRIDE + (kt * 32 + 16 * s2 + 4 * hh) * 2;
                const u32x2 lo = *(const LAS u32x2*)vp, hi2 = *(const LAS u32x2*)(vp + 16);
                u32x4 w = (u32x4){lo.x, lo.y, hi2.x, hi2.y}; vf[db][s2] = __builtin_bit_cast(bf16x8, w);
            }
#pragma unroll
        for (int qb = 0; qb < 2; ++qb) {
            f32x16 sa;
#pragma unroll
            for (int r = 0; r < 16; ++r) sa[r] = 0.f;
#pragma unroll
            for (int s4 = 0; s4 < 4; ++s4) sa = __builtin_amdgcn_mfma_f32_32x32x16_bf16(kf[s4], qf[qb][s4], sa, 0, 0, 0);
            const float relb = (float)(kt * 32 + 4 * hh - 128 - (64 * qh + 32 * qb + l31)); const float mq = mx[qb] * L2E, ns2 = nslope * L2E;
            float ls = 0.f;
            if ((kt >= 4) && (kt < 8)) {
#pragma unroll
                for (int r = 0; r < 16; ++r) { const float ar = fabsf(relb + (float)((r & 3) + 8 * (r >> 2)));
                    const float pe = __builtin_amdgcn_exp2f(fmaf(sa[r], L2E, fmaf(ns2, ar, -mq))); sa[r] = pe; ls += pe; }
            } else {
#pragma unroll
                for (int r = 0; r < 16; ++r) { const float ar = fabsf(relb + (float)((r & 3) + 8 * (r >> 2)));
                    const float pe = ar <= 128.0f ? __builtin_amdgcn_exp2f(fmaf(sa[r], L2E, fmaf(ns2, ar, -mq))) : 0.f; sa[r] = pe; ls += pe; }
            }
            lsum[qb] += ls;
#pragma unroll
            for (int s2 = 0; s2 < 2; ++s2) {
                u32x4 w; w.x = cvt_pk_bf16(sa[8 * s2 + 0], sa[8 * s2 + 1]); w.y = cvt_pk_bf16(sa[8 * s2 + 2], sa[8 * s2 + 3]); w.z = cvt_pk_bf16(sa[8 * s2 + 4], sa[8 * s2 + 5]); w.w = cvt_pk_bf16(sa[8 * s2 + 6], sa[8 * s2 + 7]);
                const bf16x8 pa = __builtin_bit_cast(bf16x8, w);
#pragma unroll
                for (int db = 0; db < 2; ++db) o[qb][db] = __builtin_amdgcn_mfma_f32_32x32x16_bf16(pa, vf[db][s2], o[qb][db], 0, 0, 0);
            }
        }
    }
    if (PF && next_pool >= 0) pool_fetch(pr, U, Wgt, next_pool, tid);
#pragma unroll
    for (int qb = 0; qb < 2; ++qb) { const float lt = lsum[qb] + __shfl_xor(lsum[qb], 32) + __builtin_amdgcn_exp2f((sink - mx[qb]) * L2E); if (hh == 0) lsc[qb * 32 + l31] = 1.0f / lt; }
    asm volatile("s_waitcnt lgkmcnt(0)" ::: "memory");
#pragma unroll
    for (int qb = 0; qb < 2; ++qb)
#pragma unroll
        for (int r = 0; r < 16; ++r) { const int q = crow(r, hh); const float li = lsc[qb * 32 + q];
            bf16_t* op = AY + (size_t)(tok0 + 64 * qh + 32 * qb + q) * DM + h * 64 + l31;
            op[0] = f2bf(o[qb][0][r] * li); op[32] = f2bf(o[qb][1][r] * li); }
    __syncthreads();
}

__device__ __forceinline__ void pool_unit(LAS unsigned char* lds, const bf16_t* __restrict__ U, const bf16_t* __restrict__ Wgt, const float* __restrict__ pscale, bf16_t* __restrict__ AY, int unit, int tid, int wave, int lane, PoolRegs& pr, int next_pool) {
    const int g = unit & 3, tt = unit >> 2, tok0 = tt * 128, t0 = tok0 % SEQ;
    LAS unsigned char* Ps = lds; LAS unsigned char* Ys = lds + PL_YS_OFF; LAS unsigned char* Ws = lds + PL_WS_OFF;
    pool_put(pr, lds, tid);
    if (next_pool >= 0) pool_fetch(pr, U, Wgt, next_pool, tid);
    __syncthreads();
    const int hw = 1 << g;
    {
        const int c8 = tid & 15, tl0 = (tid >> 4) * 4;
        f32x4 s0 = (f32x4){0.f, 0.f, 0.f, 0.f}, s1 = s0;
        for (int q = 0; q < 2 * hw; ++q) { f32x4 a0, a1; pg8::unpack8(*(const LAS u32x4*)(Ps + (tl0 + 8 - hw + q) * PL_STRIDE + c8 * 16), a0, a1); s0 = s0 + a0; s1 = s1 + a1; }
#pragma unroll
        for (int i = 0; i < 4; ++i) {
            const int tl = tl0 + i, t = t0 + tl, lo = max(t - hw, 0), hi = min(t + hw - 1, SEQ - 1);
            const float inv = 1.0f / (float)(hi - lo + 1);
            f32x4 p0, p1; pg8::unpack8(*(const LAS u32x4*)(Ps + (tl + 8) * PL_STRIDE + c8 * 16), p0, p1);
            *(LAS u32x4*)(Ys + tl * PL_STRIDE + c8 * 16) = pg8::pack8(s0 * inv - p0, s1 * inv - p1);
            if (i < 3) { f32x4 a0, a1, b0, b1; pg8::unpack8(*(const LAS u32x4*)(Ps + (tl + 8 + hw) * PL_STRIDE + c8 * 16), a0, a1); pg8::unpack8(*(const LAS u32x4*)(Ps + (tl + 8 - hw) * PL_STRIDE + c8 * 16), b0, b1);
                s0 = s0 + (a0 - b0); s1 = s1 + (a1 - b1); }
        }
    }
    __syncthreads();
    const int wr = wave >> 1, wc = wave & 1, fr = lane & 15, fq = lane >> 4;
    f32x4 acc[2][4];
#pragma unroll
    for (int m = 0; m < 2; ++m)
#pragma unroll
        for (int n = 0; n < 4; ++n) acc[m][n] = (f32x4){0.f, 0.f, 0.f, 0.f};
#pragma unroll
    for (int ks = 0; ks < 4; ++ks) {
        bf16x8 af[2], bfr[4];
#pragma unroll
        for (int m = 0; m < 2; ++m) af[m] = *(const LAS bf16x8*)(Ys + (32 * wr + 16 * m + fr) * PL_STRIDE + (32 * ks + 8 * fq) * 2);
#pragma unroll
        for (int n = 0; n < 4; ++n) bfr[n] = *(const LAS bf16x8*)(Ws + (64 * wc + 16 * n + fr) * PL_STRIDE + (32 * ks + 8 * fq) * 2);
#pragma unroll
        for (int m = 0; m < 2; ++m)
#pragma unroll
            for (int n = 0; n < 4; ++n) acc[m][n] = __builtin_amdgcn_mfma_f32_16x16x32_bf16(bfr[n], af[m], acc[m][n], 0, 0, 0);
    }
#pragma unroll
    for (int m = 0; m < 2; ++m)
#pragma unroll
        for (int n = 0; n < 4; ++n) { const int d = 64 * wc + 16 * n + 4 * fq; const f32x4 v = acc[m][n] * *(const f32x4*)(pscale + 128 * g + d);
            u32x2 o2; o2.x = cvt_pk_bf16(v[0], v[1]); o2.y = cvt_pk_bf16(v[2], v[3]);
            *(u32x2*)(AY + (size_t)(tok0 + 32 * wr + 16 * m + fr) * DM + 512 + 128 * g + d) = o2; }
    __syncthreads();
}

struct MArgs { const float* in[18]; float* out; unsigned char* ws; int ph_lo, ph_hi, li, pad; };

__global__ void __launch_bounds__(NWAVES * 64, 2) mega(MArgs a) {
    extern __shared__ __attribute__((aligned(16))) unsigned char lds_raw[];
    LAS unsigned char* lds = (LAS unsigned char*)lds_raw;
    volatile LAS unsigned* XW = (volatile LAS unsigned*)(lds + LDSX_OFF);
    const int wave = __builtin_amdgcn_readfirstlane((int)threadIdx.x >> 6);
#define PHASE_IDS const int lane = lane_id_here(); const int tid = wave * 64 + lane; (void)tid;
    const int G = gridDim.x, bx = blockIdx.x;
    const int vcu = (G % 8 == 0) ? (bx % 8) * (G / 8) + bx / 8 : bx;
#define ws (a.ws)
#define ctl ((unsigned*)(ws + WS_CTL))
#define U ((bf16_t*)(ws + WS_U))
#define AY ((bf16_t*)(ws + WS_AY))
#define MIX ((bf16_t*)(ws + WS_MIX))
#define XB ((bf16_t*)(ws + WS_XB))
#define Z ((bf16_t*)(ws + WS_Z))
#define YB ((bf16_t*)(ws + WS_XS))
#define Wint ((bf16_t*)(ws + WS_WIN))
#define Wab ((bf16_t*)(ws + WS_WAB))
#define Wot ((bf16_t*)(ws + WS_WO))
#define W1t ((bf16_t*)(ws + WS_W1))
#define W2t ((bf16_t*)(ws + WS_W2))
#define Wgt ((bf16_t*)(ws + WS_WG))
#define X8 ((unsigned char*)(ws + WS_X8))
#define Wint8 ((unsigned char*)(ws + WS_WIN8))
#define WgT ((float*)(ws + WS_WR))
#define H8 ((unsigned char*)(ws + WS_H1B))
#define slotmap ((int*)(ws + WS_RT))
#define ACT8 ((unsigned char*)(ws + WS_ACT))
#define STAT ((float*)(ws + WS_STAT))
#define te ((int*)(ws + WS_TE))
#define tg ((float*)(ws + WS_TG))
#define tr ((int*)(ws + WS_TR))
    { PHASE_IDS; if (tid < 64) XW[tid] = 0u; }
    __syncthreads();
    XcdBarrier bar = xcd_barrier_post(ctl + CW_BAR + a.li * XCD_BAR_WORDS, XW, wave);
    const int lo = a.ph_lo, hi = a.ph_hi;
    if ((PROBE_T >= 0 || PROBE_SKEW) && bx == 0 && threadIdx.x == 0) { const unsigned long long t_ = __builtin_amdgcn_s_memrealtime(); XW[8] = (unsigned)t_; XW[9] = (unsigned)(t_ >> 32); }
#define IN(k) (lo <= (k) && (k) < hi)
#ifndef PROBE_N
#define PROBE_N 2
#endif
#define NREP(k) ((k) == PROBE_PH ? PROBE_N : 1)
#define MARK(m) do { if (PROBE_T == (m) && bx == 0 && threadIdx.x == 0) { const unsigned long long t_ = __builtin_amdgcn_s_memrealtime(); XW[10] = (unsigned)t_; XW[11] = (unsigned)(t_ >> 32); } } while (0)
#ifndef PROBE_BARX
#define PROBE_BARX 0
#endif
#ifndef PROBE_BARF
#define PROBE_BARF 0
#endif
#define SEAM(k) do { MARK(2 * (k)); if (PROBE_SKEW && xb_leader(wave)) ctl[32768 + (k) * 256 + blockIdx.x] = (unsigned)__builtin_amdgcn_s_memrealtime(); if (IN(k) && IN((k) + 1)) { xcd_barrier(bar, wave); for (int bx_ = 0; bx_ < PROBE_BARX; ++bx_) xcd_barrier<PROBE_BARF>(bar, wave); } MARK(2 * (k) + 1); } while (0)

    if (IN(0)) for (int rep_ = 0; rep_ < NREP(0); ++rep_) {
        PHASE_IDS;
        LAS float* scr = (LAS float*)(lds + wave * 16384);
        const int gw = vcu * NWAVES + wave, NGW = G * NWAVES;
        constexpr int I_IN = (DM / 64) * (INW / 32), I_AB = (512 / 64) * (DM / 32), I_O = (DM / 64) * (DM / 32);
        constexpr int I_G = (128 / 64) * (128 / 32);
        constexpr int NITEMS = I_IN + 2 * I_AB + I_O + 4 * I_G;
        for (int it = gw; it < NITEMS; it += NGW) {
            int r = it;
            if (r < I_IN) { const int nb = INW / 32, n0 = 32 * (r % nb);
                if (n0 >= OP && n0 < OGA) p0_item<false>(a.in[1], INW, 64 * (r / nb), n0, Wint, DM, n0, 0, scr, lane);
                else p0_item<false, true>(a.in[1], INW, 64 * (r / nb), n0, (bf16_t*)Wint8, DM, n0, 0, scr, lane);
                continue; } r -= I_IN;
            if (r < I_AB) { const int nb = DM / 32; p0_item<false>(a.in[3], DM, 64 * (r / nb), 32 * (r % nb), Wab, DM, 32 * (r % nb), 0, scr, lane); continue; } r -= I_AB;
            if (r < I_AB) { const int nb = DM / 32; p0_item<false>(a.in[6], DM, 64 * (r / nb), 32 * (r % nb), Wab, DM, 32 * (r % nb), 512, scr, lane); continue; } r -= I_AB;
            if (r < I_O) { const int nb = DM / 32; p0_item<false, true>(a.in[7], DM, 64 * (r / nb), 32 * (r % nb), Wot, DM, 32 * (r % nb), 0, scr, lane); continue; } r -= I_O;
            { const int gg = r / I_G, q = r % I_G; p0_item<false>(a.in[4] + (size_t)gg * 128 * 128, 128, 64 * (q / 4), 32 * (q % 4), Wgt + (size_t)gg * 128 * 128, 128, 32 * (q % 4), 0, scr, lane); }
        }
        {
            const float* g1 = a.in[8]; const float* b1 = a.in[9]; const float* wr = a.in[10]; const float* br = a.in[11];
            for (int i = gw * 64 + lane; i < NE * DM; i += NGW * 64) { const int c = i >> 5, e = i & 31;
                const float w = g1[c] * wr[c * NE + e]; const bf16_t hi = f2bf(w), lo = f2bf(w - bf2f(hi));
                ((bf16_t*)WgT)[(c >> 3) * 256 + e * 8 + (c & 7)] = hi; ((bf16_t*)WgT)[NE * DM + (c >> 3) * 256 + e * 8 + (c & 7)] = lo; }
            if (gw < 64) { const int e = gw & 31, which = gw >> 5; float sacc = 0.f;
#pragma unroll
                for (int c0 = 0; c0 < DM; c0 += 64) { const int c = c0 + lane; sacc += (which ? b1[c] : g1[c]) * wr[c * NE + e]; }
                sacc = wave_sum(sacc);
                if (lane == 0) { if (which) WgT[NE * DM + 32 + e] = sacc + br[e]; else WgT[NE * DM + e] = sacc; } }
        }
        for (int i = (gw * 64 + lane) * 4; i < NE * NTOK; i += NGW * 64 * 4) *(u32x4*)(slotmap + i) = (u32x4){0u, 0u, 0u, 0u};
        const float* x = a.in[0];
        {
            constexpr int NCH = NTOK * DM / 1024, HW = NITEMS - 2048;
            const bool heavy = gw < HW && NGW == 2048;
            const int c0 = NGW != 2048 ? gw * ((NCH + NGW - 1) / NGW) : heavy ? gw * 6 : HW * 6 + (gw - HW) * 9, nc = NGW != 2048 ? (NCH + NGW - 1) / NGW : heavy ? 6 : 9;
            for (int cb = c0; cb < c0 + nc; cb += 3) {
                f32x4 v[3][2][2];
#pragma unroll
                for (int u = 0; u < 3; ++u)
#pragma unroll
                    for (int hq = 0; hq < 2; ++hq) { const size_t i = (size_t)(cb + u) * 1024 + 512 * hq + 8 * lane;
                        if (cb + u < NCH && cb + u < c0 + nc) { v[u][hq][0] = *(const f32x4*)(x + i); v[u][hq][1] = *(const f32x4*)(x + i + 4); } }
#pragma unroll
                for (int u = 0; u < 3; ++u)
#pragma unroll
                    for (int hq = 0; hq < 2; ++hq) { const size_t i = (size_t)(cb + u) * 1024 + 512 * hq + 8 * lane;
                        if (cb + u < NCH && cb + u < c0 + nc) { *(u32x4*)(XB + i) = pg8::pack8(v[u][hq][0], v[u][hq][1]);
                            u32x2 w8; w8.x = pk4_fp8(v[u][hq][0][0], v[u][hq][0][1], v[u][hq][0][2], v[u][hq][0][3]); w8.y = pk4_fp8(v[u][hq][1][0], v[u][hq][1][1], v[u][hq][1][2], v[u][hq][1][3]); *(u32x2*)(X8 + i) = w8; } }
            }
        }
    }
    SEAM(0);
    if (IN(1)) for (int rep_ = 0; rep_ < NREP(1); ++rep_) {
        { pg8::Gemm g{XB, Wint, DM, DM, DM, 0}; pg8::P1OrderA S{bx}; pg8::gemm_phase<pg8::EpiU, pg8::P1OrderA, true>(lds, g, S, pg8::EpiU{U, 1.0f}, wave); }
        asm volatile("s_waitcnt vmcnt(0)" ::: "memory"); __syncthreads();
        { pg8::Gemm g{(const bf16_t*)X8, (const bf16_t*)Wint8, DM / 2, DM / 2, DM / 2, 0}; pg8::P1OrderB S{bx}; pg8::gemm_phase<pg8::EpiU, pg8::P1OrderB, true, true>(lds, g, S, pg8::EpiU{U, WSC_INV}, wave); }
        asm volatile("s_waitcnt vmcnt(0)" ::: "memory"); __syncthreads();
        { const int lane2 = lane_id_here();
          if (bx < 128) { const int p = (bx * 8 + wave) * 3; conv_w1(a.in[12], W1t, (LAS float*)(lds + wave * 16384), 2 * p, 2 * p + 6, 0, 1, lane2); }
          else if (bx >= 192) { const int p = 3072 + ((bx - 192) * 8 + wave) * 5; conv_w1(a.in[12], W1t, (LAS float*)(lds + wave * 16384), 2 * p, 2 * p + 10, 0, 1, lane2); } }
    }
    SEAM(1);
    if (IN(2)) for (int rep_ = 0; rep_ < NREP(2); ++rep_) {
        PHASE_IDS;
        constexpr int NPU = (NTOK / 128) * 4;
        constexpr int NAU = 2 * (SEQ / 128) * 2;
        int unit = vcu;
        { PoolRegs dummy; for (; unit + G < NAU; unit += G) attn_unit<false>(lds, U, a.in[2], AY, unit, tid, wave, lane, dummy, Wgt, -1); }
        PoolRegs pr;
        if (unit < NAU) attn_unit<true>(lds, U, a.in[2], AY, unit, tid, wave, lane, pr, Wgt, vcu < NPU / 2 ? vcu : -1);
        else if (vcu < NPU / 2) pool_fetch(pr, U, Wgt, vcu, tid);
        for (int i = vcu; i < NPU / 2; i += G) { pool_unit(lds, U, Wgt, a.in[5], AY, i, tid, wave, lane, pr, NPU - 1 - i); pool_unit(lds, U, Wgt, a.in[5], AY, NPU - 1 - i, tid, wave, lane, pr, i + G < NPU / 2 ? i + G : -1); }
    }
    SEAM(2);
    if (IN(3)) for (int rep_ = 0; rep_ < NREP(3); ++rep_) {
        PHASE_IDS;
        pg8::Gemm g{AY, Wab, DM, DM, DM, 0}; pg8::StaticOrder S; S.init(NTOK, DM, G, bx, 8);
        pg8::gemm_phase<pg8::EpiMix, pg8::StaticOrder, true>(lds, g, S, pg8::EpiMix{U, MIX}, wave);
    }
    SEAM(3);
    if (IN(4)) for (int rep_ = 0; rep_ < NREP(4); ++rep_) {
        PHASE_IDS;
        pg8::Gemm g{MIX, Wot, DM / 2, DM / 2, DM / 2, 0}; pg8::StaticOrder S; S.init(NTOK, DM, G, bx, 8);
        pg8::gemm_phase<pg8::EpiZ, pg8::StaticOrder, true, true>(lds, g, S, pg8::EpiZ{XB, Z, WSC_INV / MSC}, wave);
    }
    SEAM(4);
    if (IN(5)) {
        PHASE_IDS;
        const float* g1 = a.in[8]; const float* b1 = a.in[9];
        LAS float* part = (LAS float*)lds;
        LAS float* stat = (LAS float*)(lds + 40960);
        LAS int* lcnt = (LAS int*)(lds + 41984);
        LAS int* asg_e = (LAS int*)(lds + 43008);
        LAS int* asg_r = asg_e + 256; LAS float* asg_g = (LAS float*)(asg_e + 512);
        for (int tile = bx; tile < NTOK / 64; tile += G) {
            if (tid < 64) lcnt[tid] = 0;
            {
                f32x4 v[8][4];
#pragma unroll
                for (int i = 0; i < 8; ++i)
#pragma unroll
                    for (int j = 0; j < 4; ++j) { const u32x2 zz = *(const u32x2*)(Z + (size_t)(tile * 64 + 8 * wave + i) * DM + 256 * j + 4 * lane); v[i][j] = (f32x4){bflo(zz.x), bfhi(zz.x), bflo(zz.y), bfhi(zz.y)}; }
                f32x4 gv[4], bv[4];
#pragma unroll
                for (int j = 0; j < 4; ++j) { gv[j] = *(const f32x4*)(g1 + 256 * j + 4 * lane); bv[j] = *(const f32x4*)(b1 + 256 * j + 4 * lane); }
#pragma unroll
                for (int i = 0; i < 8; ++i) {
                    const int r = 8 * wave + i, tok = tile * 64 + r; float sacc = 0.f;
#pragma unroll
                    for (int j = 0; j < 4; ++j) sacc += (v[i][j][0] + v[i][j][1]) + (v[i][j][2] + v[i][j][3]);
                    const float mean = wave_sum(sacc) * (1.0f / DM); float q = 0.f;
#pragma unroll
                    for (int j = 0; j < 4; ++j) { v[i][j] = v[i][j] - mean; q += (v[i][j][0] * v[i][j][0] + v[i][j][1] * v[i][j][1]) + (v[i][j][2] * v[i][j][2] + v[i][j][3] * v[i][j][3]); }
                    const float rstd = rsqrtf(wave_sum(q) * (1.0f / DM) + LN_EPS);
#pragma unroll
                    for (int j = 0; j < 4; ++j) { const f32x4 hv = v[i][j] * rstd * gv[j] + bv[j];
                        *(unsigned*)(H8 + (size_t)tok * DM + 256 * j + 4 * lane) = pk4_fp8(hv[0], hv[1], hv[2], hv[3]); }
                    if (lane == 0) { stat[2 * r] = mean; stat[2 * r + 1] = rstd; STAT[2 * tok] = mean; STAT[2 * tok + 1] = rstd; }
                }
            }
            {
                const int tt = wave >> 2, kq = wave & 3, half = lane >> 5, j32 = lane & 31;
                const bf16_t* zr = Z + (size_t)(tile * 64 + 32 * tt + j32) * DM + 256 * kq + 8 * half;
                const bf16_t* wrow = (const bf16_t*)WgT + (size_t)((32 * kq + half) * 32 + j32) * 8;
                f32x16 acc;
#pragma unroll
                for (int r = 0; r < 16; ++r) acc[r] = 0.f;
#pragma unroll 8
                for (int g = 0; g < 16; ++g) { const bf16x8 az = *(const bf16x8*)(zr + 16 * g), bh = *(const bf16x8*)(wrow + 512 * g), bl = *(const bf16x8*)(wrow + NE * DM + 512 * g);
                    acc = __builtin_amdgcn_mfma_f32_32x32x16_bf16(az, bl, acc, 0, 0, 0); acc = __builtin_amdgcn_mfma_f32_32x32x16_bf16(az, bh, acc, 0, 0, 0); }
#pragma unroll
                for (int r = 0; r < 16; ++r) part[((tt * 4 + kq) * 32 + ((r & 3) + 8 * (r >> 2) + 4 * half)) * 33 + j32] = acc[r];
            }
            __syncthreads();
            {
                const int e = lane & 31, hf = lane >> 5;
                const float Ge = WgT[NE * DM + e], Bce = WgT[NE * DM + 32 + e];
#pragma unroll
                for (int i = 0; i < 4; ++i) {
                    const int t = 8 * wave + 2 * i + hf; const float mean = stat[2 * t], rstd = stat[2 * t + 1];
                    const LAS float* pp = part + ((t >> 5) * 4 * 32 + (t & 31)) * 33 + e;
                    float lg = rstd * (((pp[0] + pp[32 * 33]) + (pp[2 * 32 * 33] + pp[3 * 32 * 33])) - mean * Ge) + Bce;
                    unsigned uo = __float_as_uint(lg); uo = (uo & 0x80000000u) ? ~uo : (uo | 0x80000000u);
                    unsigned key = (uo & ~31u) | (unsigned)(31 - e);
                    float sv[4]; int se[4];
#pragma unroll
                    for (int k = 0; k < 4; ++k) { const unsigned mk = max32u(key); if (key == mk) key = 0u;
                        se[k] = 31 - (int)(mk & 31u); const unsigned um = mk & ~31u; sv[k] = __uint_as_float((um & 0x80000000u) ? (um & 0x7fffffffu) : ~um); }
                    const float e1 = __expf(sv[1] - sv[0]), e2 = __expf(sv[2] - sv[0]), e3 = __expf(sv[3] - sv[0]), rs = 1.0f / (1.0f + e1 + e2 + e3);
                    if (e < 4) { const int myE = e == 0 ? se[0] : e == 1 ? se[1] : e == 2 ? se[2] : se[3]; const float myG = (e == 0 ? 1.0f : e == 1 ? e1 : e == 2 ? e2 : e3) * rs;
                        const int slot = t * 4 + e; asg_e[slot] = myE; asg_g[slot] = myG; asg_r[slot] = __hip_atomic_fetch_add(&lcnt[myE], 1, __ATOMIC_RELAXED, __HIP_MEMORY_SCOPE_WORKGROUP); }
                }
            }
            __syncthreads();
            if (tid < 32) lcnt[32 + tid] = (int)__hip_atomic_fetch_add(&ctl[tid], (unsigned)lcnt[tid], __ATOMIC_RELAXED, __HIP_MEMORY_SCOPE_AGENT);
            __syncthreads();
            if (tid < 256) { const int as = tile * 256 + tid, ee = asg_e[tid], rk = lcnt[32 + ee] + asg_r[tid]; te[as] = ee; tg[as] = asg_g[tid]; tr[as] = rk; slotmap[ee * NTOK + rk] = as >> 2; }
            __syncthreads();
        }
        {
            const int gw = vcu * NWAVES + wave, NGW = G * NWAVES;
            const int w1_first = W1_Q1;
            conv_w1(a.in[12], W1t, (LAS float*)(lds + wave * 16384), w1_first, CONV_I1, gw, NGW, lane);
        }
    }
    SEAM(5);
    if (IN(7) || IN(8)) {
        LAS int* tile_e = (LAS int*)(lds + LDSX_OFF + 256);
        LAS int* tfirst = (LAS int*)(lds + LDSX_OFF + 2048);
        if (xb_leader(wave)) { int ps = 0; for (int e = 0; e < NE; ++e) { const int nt = ((int)ctl[e] + 255) >> 8; tfirst[e] = ps; for (int i = 0; i < nt; ++i) tile_e[1 + ps + i] = e; ps += nt; } tile_e[0] = ps; }
        __syncthreads();
        const int nT = tile_e[0];
        if (IN(7)) for (int rep_ = 0; rep_ < NREP(7); ++rep_) {
            pg8::Gemm g{(const bf16_t*)H8, W1t, DM / 2, DM / 2, DM / 2, (size_t)2 * DE * DM}; pg8::MoeOrder S{nT, DE / 128, nT * (DE / 128), G, bx, tile_e + 1};
            LAS unsigned short* rowlds = (LAS unsigned short*)(lds + LDSX_OFF + 4096);
            LAS bf16_t* bl1 = (LAS bf16_t*)(lds + LDSX_OFF + 4096 + 5120);
            { PHASE_IDS; pg8::Unit u; const float* b1g = a.in[13];
              for (int i = 0; i < 10 && S.next(i, u); ++i) if (tid < 256) { rowlds[i * 256 + tid] = (unsigned short)slotmap[u.e * NTOK + (u.pm - tfirst[u.e]) * 256 + tid];
                  bl1[i * 256 + tid] = f2bf(b1g[(size_t)u.e * 2 * DE + (tid >> 7) * DE + u.pn * 128 + (tid & 127)]); } }
            __syncthreads();
            pg8::gemm_phase<pg8::EpiAct, pg8::MoeOrder, true, true, true>(lds, g, S, pg8::EpiAct{bl1, ACT8}, wave, rowlds);
            asm volatile("s_waitcnt vmcnt(0)" ::: "memory"); __syncthreads();
            {
                const int nU = nT * (DE / 128), rounds = (nU + G - 1) / G, nlong = nU - (rounds - 1) * G, nshort = G - nlong;
                const int front = min(nshort * NWAVES * 8, CONV_I2);
                const int lane2 = lane_id_here();
                if (bx >= nlong) conv_w2(a.in[14], W2t, (LAS float*)(lds + wave * 16384), 0, front, (bx - nlong) * NWAVES + wave, nshort * NWAVES, lane2);
                conv_w2(a.in[14], W2t, (LAS float*)(lds + wave * 16384), front, CONV_I2, vcu * NWAVES + wave, G * NWAVES, lane2);
            }
        }
        SEAM(7);
        if (IN(8)) for (int rep_ = 0; rep_ < NREP(8); ++rep_) {
            pg8::Gemm g{(const bf16_t*)ACT8, W2t, DE / 2, DE / 2, DE / 2, (size_t)DM * DE}; pg8::MoeOrder S{nT, DM / 256, nT * (DM / 256), G, bx, tile_e + 1};
            LAS float* bl2 = (LAS float*)(lds + LDSX_OFF + 4096);
            { PHASE_IDS; pg8::Unit u; const float* b2g = a.in[15]; for (int i = 0; i < 10 && S.next(i, u); ++i) if (tid < 256) bl2[i * 256 + tid] = b2g[(size_t)u.e * DM + u.pn * 256 + tid]; }
            __syncthreads();
            pg8::gemm_phase<pg8::EpiY, pg8::MoeOrder, true, true>(lds, g, S, pg8::EpiY{bl2, YB}, wave);
        }
    }
    SEAM(8);
    if (IN(9)) for (int rep_ = 0; rep_ < NREP(9); ++rep_) {
        PHASE_IDS;
        const float* g1 = a.in[8]; const float* b1 = a.in[9]; const float* g2 = a.in[16]; const float* b2 = a.in[17];
        const int gw = vcu * NWAVES + wave, NGW = G * NWAVES;
        LAS int* pst = (LAS int*)(lds + LDSX_OFF + 2048);
        if (tid == 0) { int ps = 0; for (int e = 0; e < NE; ++e) { pst[e] = ps; ps += (((int)ctl[e] + 255) >> 8) << 8; } }
        __syncthreads();
        f32x4 g1v[4], b1v[4], g2v[4], b2v[4];
#pragma unroll
        for (int j = 0; j < 4; ++j) { const int c = 512 * (j >> 1) + 8 * lane + 4 * (j & 1); g1v[j] = *(const f32x4*)(g1 + c); b1v[j] = *(const f32x4*)(b1 + c); g2v[j] = *(const f32x4*)(g2 + c); b2v[j] = *(const f32x4*)(b2 + c); }
        typedef int i32x4_t __attribute__((ext_vector_type(4)));
        f32x2 nst = *(const f32x2*)(STAT + 2 * gw); i32x4_t nte = *(const i32x4_t*)(te + gw * 4), ntr = *(const i32x4_t*)(tr + gw * 4); f32x4 nwk = *(const f32x4*)(tg + gw * 4);
        for (int tok = gw; tok < NTOK; tok += NGW) {
            const float mean1 = nst[0], rstd1 = nst[1];
            int dk[4]; float wk[4];
#pragma unroll
            for (int k = 0; k < 4; ++k) { dk[k] = pst[nte[k]] + ntr[k]; wk[k] = nwk[k]; }
            { const int nt_ = tok + NGW < NTOK ? tok + NGW : tok;
              nst = *(const f32x2*)(STAT + 2 * nt_); nte = *(const i32x4_t*)(te + nt_ * 4); ntr = *(const i32x4_t*)(tr + nt_ * 4); nwk = *(const f32x4*)(tg + nt_ * 4); }
            f32x4 v[4]; float sacc = 0.f;
#pragma unroll
            for (int ch = 0; ch < 2; ++ch) { const int c = 512 * ch + 8 * lane;
                f32x4 z0, z1; pg8::unpack8(*(const u32x4*)(Z + (size_t)tok * DM + c), z0, z1);
                f32x4 f0 = (f32x4){0.f, 0.f, 0.f, 0.f}, f1 = f0;
#pragma unroll
                for (int k = 0; k < 4; ++k) { f32x4 y0, y1; pg8::unpack8(*(const u32x4*)(YB + (size_t)dk[k] * DM + c), y0, y1); f0 = f0 + wk[k] * y0; f1 = f1 + wk[k] * y1; }
                v[2 * ch] = ALPHA * ((z0 - mean1) * rstd1 * g1v[2 * ch] + b1v[2 * ch]) + f0; v[2 * ch + 1] = ALPHA * ((z1 - mean1) * rstd1 * g1v[2 * ch + 1] + b1v[2 * ch + 1]) + f1;
                sacc += ((v[2 * ch][0] + v[2 * ch][1]) + (v[2 * ch][2] + v[2 * ch][3])) + ((v[2 * ch + 1][0] + v[2 * ch + 1][1]) + (v[2 * ch + 1][2] + v[2 * ch + 1][3])); }
            const float mean = wave_sum(sacc) * (1.0f / DM); float q = 0.f;
#pragma unroll
            for (int j = 0; j < 4; ++j) { v[j] = v[j] - mean; q += (v[j][0] * v[j][0] + v[j][1] * v[j][1]) + (v[j][2] * v[j][2] + v[j][3] * v[j][3]); }
            const float rstd = rsqrtf(wave_sum(q) * (1.0f / DM) + LN_EPS);
#pragma unroll
            for (int j = 0; j < 4; ++j) { const int c = 512 * (j >> 1) + 8 * lane + 4 * (j & 1); *(f32x4*)(a.out + (size_t)tok * DM + c) = v[j] * rstd * g2v[j] + b2v[j]; }
        }
    }
    if (PROBE_SKEW) {
        if (xb_leader(wave)) ctl[32768 + 9 * 256 + blockIdx.x] = (unsigned)__builtin_amdgcn_s_memrealtime();
        xcd_barrier(bar, wave);
        if (bx == 0) {
            const unsigned t0 = XW[8];
            for (int k = 0; k < 10; ++k) if ((PROBE_SKEW >> k) & 1) { if ((int)threadIdx.x < G) { const unsigned d = ctl[32768 + k * 256 + threadIdx.x] - t0;
                __hip_atomic_fetch_max((LAS unsigned*)&XW[16 + k], d, __ATOMIC_RELAXED, __HIP_MEMORY_SCOPE_WORKGROUP); __hip_atomic_fetch_add((LAS unsigned*)&XW[32 + k], d, __ATOMIC_RELAXED, __HIP_MEMORY_SCOPE_WORKGROUP); } }
            __syncthreads();
            if (threadIdx.x == 0) { unsigned tot = 0; for (int k = 0; k < 10; ++k) if ((PROBE_SKEW >> k) & 1) tot += XW[16 + k] - XW[32 + k] / (unsigned)G;
                const unsigned long long t1 = __builtin_amdgcn_s_memrealtime(); while (__builtin_amdgcn_s_memrealtime() - t1 < (unsigned long long)tot) __builtin_amdgcn_s_sleep(8); }
        }
    }
    if (PROBE_T >= 0 && bx == 0 && threadIdx.x == 0) { const unsigned long long tstart = XW[8] | ((unsigned long long)XW[9] << 32), tmark = XW[10] | ((unsigned long long)XW[11] << 32); const unsigned long long dt = tmark - tstart, t1 = __builtin_amdgcn_s_memrealtime(); while (__builtin_amdgcn_s_memrealtime() - t1 < dt) __builtin_amdgcn_s_sleep(8); }
#undef IN
#undef SEAM
#undef ws
#undef ctl
#undef U
#undef AY
#undef MIX
#undef XB
#undef Z
#undef YB
#undef Wint
#undef Wab
#undef Wot
#undef W1t
#undef W2t
#undef Wgt
#undef X8
#undef Wint8
#undef WgT
#undef H8
#undef slotmap
#undef ACT8
#undef STAT
#undef te
#undef tg
#undef tr
}

extern "C" void kernel_launch(void* const* d_in, const int* in_sizes, int n_in, void* d_out, int out_size, void* d_ws, size_t ws_size, hipStream_t stream) {
    static int grid = 0;
    if (grid == 0) {
        if (n_in != 18 || ws_size < WS_END) { fprintf(stderr, "kernel_launch: unexpected n_in %d / ws_size %zu (need %zu)\n", n_in, ws_size, (size_t)WS_END); grid = -1; return; }
        int dev = 0, cus = 0;
        if (hipGetDevice(&dev) != hipSuccess || hipDeviceGetAttribute(&cus, hipDeviceAttributeMultiprocessorCount, dev) != hipSuccess) { grid = -1; return; }
        if (hipFuncSetAttribute((const void*)mega, hipFuncAttributeMaxDynamicSharedMemorySize, LDS_BYTES) != hipSuccess) { fprintf(stderr, "kernel_launch: hipFuncSetAttribute failed\n"); grid = -1; return; }
        grid = cus;
    }
    if (grid < 0) return;
    const float* x = (const float*)d_in[0]; const float* sinks = (const float*)d_in[2];
    const float* w_pg = (const float*)d_in[4]; const float* pscale = (const float*)d_in[5];
    const float* ln1g = (const float*)d_in[8]; const float* ln1b = (const float*)d_in[9]; const float* w_r = (const float*)d_in[10]; const float* b_r = (const float*)d_in[11];
    const float* ln2g = (const float*)d_in[16]; const float* ln2b = (const float*)d_in[17];
    char* ws = (char*)d_ws; float* out = (float*)d_out;
    int* ctl = (int*)(ws + WS_CTL); bf16_t* U = (bf16_t*)(ws + WS_U); bf16_t* AY = (bf16_t*)(ws + WS_AY);
    bf16_t* H1B = (bf16_t*)(ws + WS_H1B); float* Z = (float*)(ws + WS_Z); float* STAT = (float*)(ws + WS_STAT);
    int* te = (int*)(ws + WS_TE); float* tg = (float*)(ws + WS_TG); int* tr = (int*)(ws + WS_TR); int* td = (int*)(ws + WS_TD);
    bf16_t* XS = (bf16_t*)(ws + WS_XS); bf16_t* YB = XS;
    (void)x; (void)in_sizes; (void)out_size;

    if (hipMemsetAsync(ctl, 0, (size_t)(CW_BAR + 5 * XCD_BAR_WORDS) * 4, stream) != hipSuccess) return;
    MArgs a{};
    for (int i = 0; i < 18; ++i) a.in[i] = (const float*)d_in[i];
    a.out = out; a.ws = (unsigned char*)d_ws;
    a.ph_lo = 0; a.ph_hi = 10; a.li = 0;
    hipLaunchKernelGGL(mega, dim3(grid), dim3(NWAVES * 64), LDS_BYTES, stream, a);
#if defined(PROBE_LPH)
#ifndef PROBE_SUB
#define PROBE_SUB 0
#endif
    for (int r = 0; r < PROBE_LN; ++r) { a.ph_lo = PROBE_LPH; a.ph_hi = PROBE_LPH + 1; a.li = 1 + r; a.pad = PROBE_SUB; hipLaunchKernelGGL(mega, dim3(grid), dim3(NWAVES * 64), LDS_BYTES, stream, a); }
#endif
}
```

```cpp
#include <hip/hip_runtime.h>
#include <stdint.h>
#include <cstdio>

typedef unsigned short bf16_t;
typedef short bf16x8 __attribute__((ext_vector_type(8)));
typedef float f32x4 __attribute__((ext_vector_type(4)));

constexpr int NTOK = 16384, DM = 1024, SEQ = 8192, INW = 3328;
constexpr int OQ = 0, OKK = 512, OV = 640, OP = 768, OGA = 1280, OGP = 2304;
constexpr int NE = 32, TOPK = 4, DE = 1024;
constexpr int MAXROWS = NTOK * TOPK + NE * 256;
constexpr int MAXTILES = MAXROWS / 256;
constexpr float ALPHA = 1.189207115002721f;
constexpr float LN_EPS = 1e-5f;

constexpr size_t WS_CTL = 0, CTL_BYTES = 262144;
constexpr size_t WS_U = CTL_BYTES;
constexpr size_t SZ_U = (size_t)NTOK * INW * 2;
constexpr size_t SZ_A16 = (size_t)NTOK * DM * 2;
constexpr size_t WS_AY = WS_U + SZ_U;
constexpr size_t WS_MIX = WS_AY + SZ_A16;
constexpr size_t WS_H1B = WS_MIX + SZ_A16;
constexpr size_t WS_XB = WS_H1B + SZ_A16;
constexpr size_t WS_Z = WS_XB + SZ_A16;
constexpr size_t WS_STAT = WS_Z + (size_t)NTOK * DM * 4;
constexpr size_t WS_TE = WS_STAT + (size_t)NTOK * 8;
constexpr size_t WS_TG = WS_TE + (size_t)NTOK * 16;
constexpr size_t WS_TR = WS_TG + (size_t)NTOK * 16;
constexpr size_t WS_TD = WS_TR + (size_t)NTOK * 16;
constexpr size_t WS_XS = WS_TD + (size_t)NTOK * 16;
constexpr size_t SZ_XS = (size_t)MAXROWS * DM * 2;
constexpr size_t WS_ACT = WS_XS + SZ_XS;
constexpr size_t WS_WIN = WS_ACT + SZ_XS;
constexpr size_t WS_WAB = WS_WIN + (size_t)INW * DM * 2;
constexpr size_t WS_WO = WS_WAB + (size_t)DM * DM * 2;
constexpr size_t WS_WG = WS_WO + (size_t)DM * DM * 2;
constexpr size_t WS_W1 = WS_WG + (size_t)4 * 128 * 128 * 2;
constexpr size_t WS_W2 = WS_W1 + (size_t)NE * 2 * DE * DM * 2;
constexpr size_t WS_WR = WS_W2 + (size_t)NE * DE * DM * 2;
constexpr size_t WS_RT = WS_WR + (size_t)NE * DM * 4 + 256;
constexpr size_t WS_X8 = WS_RT + (size_t)NE * NTOK * 4;
constexpr size_t WS_WIN8 = WS_X8 + (size_t)NTOK * DM;
constexpr size_t WS_END = WS_WIN8 + (size_t)INW * DM;
constexpr int CW_BAR = 4096;

__device__ __forceinline__ bf16_t f2bf(float f) { uint32_t u = __float_as_uint(f); u += 0x7fffu + ((u >> 16) & 1u); return (bf16_t)(u >> 16); }
__device__ __forceinline__ float bf2f(bf16_t b) { return __uint_as_float(((uint32_t)b) << 16); }
__device__ __forceinline__ float sigmoidf_(float x) { return 1.0f / (1.0f + __expf(-x)); }

template <int CTRL> __device__ __forceinline__ float dppf(float v) { return __builtin_bit_cast(float, __builtin_amdgcn_update_dpp(0, __builtin_bit_cast(int, v), CTRL, 0xf, 0xf, true)); }
template <int CTRL> __device__ __forceinline__ unsigned dppu(unsigned v) { return (unsigned)__builtin_amdgcn_update_dpp(0, (int)v, CTRL, 0xf, 0xf, true); }
__device__ __forceinline__ float wave_sum(float v) {
    v += dppf<0xB1>(v); v += dppf<0x4E>(v); v += dppf<0x141>(v); v += dppf<0x140>(v);
    const float s0 = __builtin_bit_cast(float, __builtin_amdgcn_readlane(__builtin_bit_cast(int, v), 0)), s1 = __builtin_bit_cast(float, __builtin_amdgcn_readlane(__builtin_bit_cast(int, v), 16));
    const float s2 = __builtin_bit_cast(float, __builtin_amdgcn_readlane(__builtin_bit_cast(int, v), 32)), s3 = __builtin_bit_cast(float, __builtin_amdgcn_readlane(__builtin_bit_cast(int, v), 48));
    return (s0 + s1) + (s2 + s3);
}
__device__ __forceinline__ unsigned max32u(unsigned k) {
    k = max(k, dppu<0xB1>(k)); k = max(k, dppu<0x4E>(k)); k = max(k, dppu<0x141>(k)); k = max(k, dppu<0x140>(k));
    const auto r = __builtin_amdgcn_permlane16_swap(k, k, false, false);
    return max(r[0], r[1]);
}
__device__ __forceinline__ float wave_max(float v) {
#pragma unroll
    for (int o = 1; o < 64; o <<= 1) v = fmaxf(v, __shfl_xor(v, o));
    return v;
}

#ifndef PROBE_T
#define PROBE_T -1
#endif
#ifndef PROBE_SKEW
#define PROBE_SKEW 0
#endif
#ifndef PROBE_PH
#define PROBE_PH -1
#endif
#define LAS __attribute__((address_space(3)))
typedef unsigned u32x4 __attribute__((ext_vector_type(4)));
typedef float f32x2 __attribute__((ext_vector_type(2)));
typedef unsigned u32x2 __attribute__((ext_vector_type(2)));
typedef int i32x8 __attribute__((ext_vector_type(8)));
constexpr float WSC = 32.0f, WSC_INV = 1.0f / 32.0f, MSC = 16.0f;
__device__ __forceinline__ unsigned pk4_fp8(float a, float b, float c, float d) { int w = __builtin_amdgcn_cvt_pk_fp8_f32(a, b, 0, false); w = __builtin_amdgcn_cvt_pk_fp8_f32(c, d, w, true); return (unsigned)w; }
typedef float f32x16 __attribute__((ext_vector_type(16)));
constexpr int NWAVES = 8;
constexpr int RING_BYTES = 131072;
constexpr int LDSX_OFF = RING_BYTES;
constexpr int LDS_BYTES = 147456;

typedef __bf16 bf16x2_t __attribute__((ext_vector_type(2)));
__device__ __forceinline__ unsigned cvt_pk_bf16(float lo, float hi) { f32x2 v = {lo, hi}; bf16x2_t b = __builtin_convertvector(v, bf16x2_t); return __builtin_bit_cast(unsigned, b); }
__device__ __forceinline__ float fast_sigmoid(float x) { return __builtin_amdgcn_rcpf(1.0f + __expf(-x)); }
__device__ __forceinline__ float bflo(unsigned w) { return __uint_as_float(w << 16); }
__device__ __forceinline__ float bfhi(unsigned w) { return __uint_as_float(w & 0xffff0000u); }

__device__ __forceinline__ int lane_id_here() { int l; asm volatile("v_mbcnt_lo_u32_b32 %0, -1, 0\n\tv_mbcnt_hi_u32_b32 %0, -1, %0" : "=v"(l)); return l; }
#define XB_TMO      128
#define XB_XCNT(j)  (256  + 64 * (j))
#define XB_XSUB(j)  (1280 + 64 * (j))
#define XB_XGEN(j)  (2304 + 64 * (j))
#define XB_TOP      3328
#define XB_TOPGEN   3392
#define XCD_BAR_WORDS 3456
#define XB_SPIN_CAP (1u << 18)
__device__ __forceinline__ unsigned xb_ld(unsigned* p)              { return __hip_atomic_load(p, __ATOMIC_RELAXED, __HIP_MEMORY_SCOPE_AGENT); }
__device__ __forceinline__ unsigned xb_add(unsigned* p, unsigned v) { return __hip_atomic_fetch_add(p, v, __ATOMIC_RELAXED, __HIP_MEMORY_SCOPE_AGENT); }
__device__ __forceinline__ unsigned xb_xcc_id() { return (unsigned)__builtin_amdgcn_s_getreg((3 << 11) | 20) & 0xFu; }
#define XB_SPIN(cond, bar) do { unsigned _sp = 0; while (cond) { __builtin_amdgcn_s_sleep(1); \
    if ((++_sp & 255u) == 0u) { if (xb_ld(&(bar)[XB_TMO])) break; if (_sp > XB_SPIN_CAP) { atomicAdd(&(bar)[XB_TMO], 1u); break; } } } } while (0)
struct XcdBarrier { unsigned* bar; unsigned x; volatile LAS unsigned* st; };
__device__ __forceinline__ bool xb_leader(int wave) { return wave == 0 && __builtin_amdgcn_mbcnt_hi(~0u, __builtin_amdgcn_mbcnt_lo(~0u, 0u)) == 0u; }
__device__ __forceinline__ XcdBarrier xcd_barrier_post(unsigned* bar, volatile LAS unsigned* st, int wave) {
    XcdBarrier b; b.bar = bar; b.x = xb_xcc_id(); b.st = st;
    if (xb_leader(wave)) (void)xb_add(&bar[XB_XCNT(b.x)], 1u);
    return b;
}
__device__ __forceinline__ void xcd_barrier_complete(unsigned* bar, unsigned x, unsigned& nloc, unsigned& nx) {
    const unsigned G = gridDim.x * gridDim.y * gridDim.z;
    unsigned sum, cnt, mine, sp = 0u;
    for (;;) {
        sum = 0u; cnt = 0u; mine = 0u;
#pragma unroll
        for (unsigned j = 0; j < 16; ++j) { const unsigned c = xb_ld(&bar[XB_XCNT(j)]); sum += c; cnt += (c > 0u) ? 1u : 0u; mine = (j == x) ? c : mine; }
        if (sum == G) break;
        __builtin_amdgcn_s_sleep(1);
        if ((++sp & 255u) == 0u) { if (xb_ld(&bar[XB_TMO])) break; if (sp > XB_SPIN_CAP) { atomicAdd(&bar[XB_TMO], 1u); break; } }
    }
    nloc = mine > 0u ? mine : 1u; nx = cnt > 0u ? cnt : 1u;
}
template <int NOFENCE = 0>
__device__ __forceinline__ void xcd_barrier(const XcdBarrier& b, int wave) {
    asm volatile("s_waitcnt vmcnt(0)" ::: "memory");
    __syncthreads();
    if (xb_leader(wave)) {
        unsigned* bar = b.bar;
        __builtin_amdgcn_s_waitcnt(0);
        unsigned nloc = b.st[0], nx = b.st[1];
        if (nloc == 0u) { xcd_barrier_complete(bar, b.x, nloc, nx); b.st[0] = nloc; b.st[1] = nx; }
        unsigned old;
        { unsigned* xs = &bar[XB_XSUB(b.x)];
          asm volatile("global_atomic_add %0, %1, %2, %3 sc0\n\tbuffer_inv sc1\n\ts_waitcnt vmcnt(1)" : "=&v"(old) : "v"(0u), "v"(1u), "s"(xs) : "memory"); }
        const unsigned gen = old / nloc;
        if (old + 1u == (gen + 1u) * nloc) {
            if (!(NOFENCE & 1)) __builtin_amdgcn_fence(__ATOMIC_RELEASE, "agent");
            asm volatile("s_waitcnt vmcnt(0)" ::: "memory");
            (void)xb_add(&bar[XB_TOP], 1u);
        }
        const unsigned target = (gen + 1u) * nx;
        XB_SPIN((int)(xb_ld(&bar[XB_TOP]) - target) < 0, bar);
        asm volatile("s_waitcnt vmcnt(0)" ::: "memory");
    }
    __syncthreads();
}

namespace pg8 {
constexpr int BM = 256, BK = 64, HALF = 128, HTB = HALF * BK * 2, STAGE_BYTES = 8 * HTB, NXCD = 8;
__host__ __device__ __forceinline__ int lds_byte(int r, int c) { const int st = (r >> 4) * 2 + (c >> 5), rr = r & 15, cc = c & 31, ob = rr * 64 + cc * 2; return st * 1024 + (ob ^ (((ob >> 9) & 1) << 5)); }
__host__ __device__ __forceinline__ void stage_rc(int b, int& R, int& C) { const int st = b / 1024, sb = b % 1024, swz = sb ^ (((sb >> 9) & 1) << 5); R = (st >> 1) * 16 + swz / 64; C = (st & 1) * 32 + (swz % 64) / 2; }
__host__ __device__ __forceinline__ int perm32(int rho) { const int n = rho >> 4, i = rho & 15; return 8 * (i >> 2) + 4 * n + (i & 3); }

struct Unit { int pm, pn, e, ord, last; };
struct Gemm { const bf16_t* A; const bf16_t* Bt; int K, lda, ldb; size_t bstrideE; };

struct StaticOrder {
    int nM, nN, nwg, G, c, wgm;
    __device__ __forceinline__ void init(int M, int N, int G_, int c_, int wgm_) { nM = M / BM; nN = N / BM; nwg = nM * nN; G = G_; c = c_; wgm = wgm_; }
    __device__ __forceinline__ bool next(int i, Unit& u) const {
        const int L = i * G + c; if (L >= nwg) return false;
        int wgid = (int)L; { const int q = nwg / NXCD, r = nwg % NXCD, xcd = wgid % NXCD, off = wgid / NXCD; wgid = (xcd < r ? xcd * (q + 1) : r * (q + 1) + (xcd - r) * q) + off; }
        const int nig = wgm * nN, gid = wgid / nig, fm = gid * wgm, gsz = (nM - fm) < wgm ? (nM - fm) : wgm;
        u.pm = fm + ((wgid % nig) % gsz); u.pn = (wgid % nig) / gsz; u.e = 0; u.ord = i; return true;
    }
};
struct P1OrderA { int c;
    __device__ __forceinline__ bool next(int i, Unit& u) const { if (i > 0 || c >= 128) return false; u.pm = c >> 1; u.pn = 3 + (c & 1); u.e = 0; u.ord = 0; return true; } };
struct P1OrderB { int c;
    __device__ __forceinline__ bool next(int i, Unit& u) const {
        int U;
        if (c < 128) { if (i >= 2) return false; U = c + 128 * i; }
        else if (c < 192) { if (i >= 4) return false; U = 256 + (c - 128) + 64 * i; }
        else { if (i >= 3) return false; U = 512 + (c - 192) + 64 * i; }
        const int t = U % 11; u.pm = U / 11; u.pn = t < 3 ? t : t + 2; u.e = 0; u.ord = i; return true; } };
struct MoeOrder {
    int nT, nN, nwg, G, c; const LAS int* tile_e;
    __device__ __forceinline__ bool next(int i, Unit& u) const {
        const int L = i * G + c; if (L >= nwg) return false;
        int wgid = (int)L; { const int q = nwg / NXCD, r = nwg % NXCD, xcd = wgid % NXCD, off = wgid / NXCD; wgid = (xcd < r ? xcd * (q + 1) : r * (q + 1) + (xcd - r) * q) + off; }
        const int nig = 4 * nN, gid = wgid / nig, fm = gid * 4, gsz = (nT - fm) < 4 ? (nT - fm) : 4;
        u.pm = fm + ((wgid % nig) % gsz); u.pn = (wgid % nig) / gsz; u.e = __builtin_amdgcn_readfirstlane(tile_e[u.pm]); u.ord = i; return true;
    }
};

typedef f32x4 Acc[2][2][4][2];
__device__ __forceinline__ i32x8 ld8x(const LAS unsigned char* p0, const LAS unsigned char* p1) { typedef int i32x4 __attribute__((ext_vector_type(4))); const i32x4 a = *(const LAS i32x4*)p0, b = *(const LAS i32x4*)p1; return __builtin_shufflevector(a, b, 0, 1, 2, 3, 4, 5, 6, 7); }
__device__ __forceinline__ i32x8 join8(bf16x8 lo, bf16x8 hi) { typedef int i32x4 __attribute__((ext_vector_type(4))); const i32x4 a = __builtin_bit_cast(i32x4, lo), b = __builtin_bit_cast(i32x4, hi); return __builtin_shufflevector(a, b, 0, 1, 2, 3, 4, 5, 6, 7); }

template <class Epi, class Sched, bool ALIGN_EPI, bool FP8 = false, bool GATHER = false>
__device__ __forceinline__ void gemm_phase(LAS unsigned char* lds, const Gemm g, const Sched& S, const Epi& E, int wid, const LAS unsigned short* rowlds = nullptr) {
    const int lane = (int)__builtin_amdgcn_mbcnt_hi(~0u, __builtin_amdgcn_mbcnt_lo(~0u, 0u)), tid = wid * 64 + lane, wr = wid >> 2, wc = wid & 3, fr = lane & 15, fq = lane >> 4;
    const int nt = g.K / BK;
    unsigned voffA, voffB; unsigned gRC;
    { int R, C; stage_rc(tid * 16, R, C); const int Rb = Epi::PERM ? ((R & ~31) + perm32(R & 31)) : R;
      voffA = (unsigned)(R * g.lda + C) * 2u; voffB = (unsigned)(Rb * g.ldb + C) * 2u; gRC = ((unsigned)R << 8) | ((unsigned)C * 2u); }
    const size_t kstep = (size_t)(BK * 2);
    const size_t hstepA = (size_t)HALF * g.lda * 2, hstepB = (size_t)HALF * g.ldb * 2;
    const size_t tstepA = 2 * hstepA, tstepB = 2 * hstepB;
    const size_t dlt_voffA = hstepA / 2, dlt_voffB = hstepB / 2;
    const unsigned ldsw = (unsigned)(uintptr_t)lds + (unsigned)wid * 1024u;
    const int aoff = FP8 ? (lds_byte(wr * 64 + fr, fq * 16) | ((fq & 1) << 4)) : lds_byte(wr * 64 + fr, fq * 8), boff = FP8 ? (lds_byte(wc * 32 + fr, fq * 16) | ((fq & 1) << 4)) : lds_byte(wc * 32 + fr, fq * 8);
#define PG8_SA(b, h) (((b) * 2 + (h)) * HTB)
#define PG8_SB(b, h) ((4 + (b) * 2 + (h)) * HTB)
#define PG8_STAGE(bufoff, gbase, voff) do { _Pragma("unroll") for (int _i = 0; _i < 2; ++_i) \
        asm volatile("s_mov_b32 m0, %0\n\ts_nop 0\n\tglobal_load_lds_dwordx4 %1, %2" :: "s"(ldsw + (unsigned)((bufoff) + _i * 8192)), "v"(voff), "s"((gbase) + _i * dlt_##voff) : "m0", "memory"); } while (0)
#define XSTA(bufoff, ptr, urow, h) do { if constexpr (GATHER) { _Pragma("unroll") for (int _i = 0; _i < 2; ++_i) { const unsigned vo_ = (unsigned)*(const LAS unsigned short*)((const LAS unsigned char*)rowlds + ((gRC >> 8) << 1) + (unsigned)__builtin_amdgcn_readfirstlane((urow) * 512 + (h) * 256 + _i * 128)) * (unsigned)DM + (gRC & 255u); \
        asm volatile("s_mov_b32 m0, %0\n\ts_nop 0\n\tglobal_load_lds_dwordx4 %1, %2" :: "s"(ldsw + (unsigned)((bufoff) + _i * 8192)), "v"(vo_), "s"(ptr) : "m0", "memory"); } } \
        else PG8_STAGE(bufoff, (ptr) + (h) * hstepA, voffA); } while (0)
#define PG8_LDA(dst, b, h) do { _Pragma("unroll") for (int m = 0; m < 4; ++m) _Pragma("unroll") for (int k = 0; k < 2; ++k) dst[m][k] = *(const LAS bf16x8*)(lds + PG8_SA(b, h) + aoff + m * 2048 + k * 1024); } while (0)
#define PG8_LDB(dst, b, h) do { _Pragma("unroll") for (int n = 0; n < 2; ++n) _Pragma("unroll") for (int k = 0; k < 2; ++k) dst[n][k] = *(const LAS bf16x8*)(lds + PG8_SB(b, h) + boff + n * 2048 + k * 1024); } while (0)
#define PG8_MMA16(ai, bj, At, Bt) do { __builtin_amdgcn_s_setprio(1); _Pragma("unroll") for (int m = 0; m < 4; ++m) _Pragma("unroll") for (int n = 0; n < 2; ++n) _Pragma("unroll") for (int k = 0; k < 2; ++k) \
        acc[ai][bj][m][n] = __builtin_amdgcn_mfma_f32_16x16x32_bf16(Bt[n][k], At[m][k], acc[ai][bj][m][n], 0, 0, 0); __builtin_amdgcn_s_setprio(0); } while (0)
#define PG8_LDA8(dst, b, h) do { _Pragma("unroll") for (int m = 0; m < 4; ++m) dst[m] = ld8x(lds + PG8_SA(b, h) + aoff + m * 2048, lds + PG8_SA(b, h) + (aoff ^ 16) + m * 2048); } while (0)
#define PG8_LDB8(dst, b, h) do { _Pragma("unroll") for (int n = 0; n < 2; ++n) dst[n] = ld8x(lds + PG8_SB(b, h) + boff + n * 2048, lds + PG8_SB(b, h) + (boff ^ 16) + n * 2048); } while (0)
#define PG8_MMA8(ai, bj, At, Bt) do { __builtin_amdgcn_s_setprio(1); _Pragma("unroll") for (int m = 0; m < 4; ++m) _Pragma("unroll") for (int n = 0; n < 2; ++n) \
        acc[ai][bj][m][n] = __builtin_amdgcn_mfma_scale_f32_16x16x128_f8f6f4(Bt[n], At[m], acc[ai][bj][m][n], 0, 0, 0, 0, 0, 0); __builtin_amdgcn_s_setprio(0); } while (0)
#define PG8_WAIT_V(n) asm volatile("s_waitcnt vmcnt(" #n ")" ::: "memory")
#define PG8_WAIT_L(n) asm volatile("s_waitcnt lgkmcnt(" #n ")" ::: "memory")
#define PG8_BAR __builtin_amdgcn_s_barrier()
#define PG8_SCHED __builtin_amdgcn_sched_barrier(0)
    Unit cur, nxt; int ui = 0;
    if (!S.next(0, cur)) return;
    Acc acc;
#pragma unroll
    for (int a = 0; a < 2; ++a)
#pragma unroll
        for (int b = 0; b < 2; ++b)
#pragma unroll
            for (int m = 0; m < 4; ++m)
#pragma unroll
                for (int n = 0; n < 2; ++n) acc[a][b][m][n] = (f32x4){0.f, 0.f, 0.f, 0.f};
    bf16x8 At[FP8 ? 1 : 4][2], B0[FP8 ? 1 : 2][2], B1[FP8 ? 1 : 2][2]; i32x8 At8[FP8 ? 4 : 1], B08[FP8 ? 2 : 1], B18[FP8 ? 2 : 1];
#define XLDA(b, h) do { if constexpr (FP8) PG8_LDA8(At8, b, h); else PG8_LDA(At, b, h); } while (0)
#define XLDB0(b, h) do { if constexpr (FP8) PG8_LDB8(B08, b, h); else PG8_LDB(B0, b, h); } while (0)
#define XLDB1(b, h) do { if constexpr (FP8) PG8_LDB8(B18, b, h); else PG8_LDB(B1, b, h); } while (0)
#define XMMA0(ai, bj) do { if constexpr (FP8) PG8_MMA8(ai, bj, At8, B08); else PG8_MMA16(ai, bj, At, B0); } while (0)
#define XMMA1(ai, bj) do { if constexpr (FP8) PG8_MMA8(ai, bj, At8, B18); else PG8_MMA16(ai, bj, At, B1); } while (0)
    const char* cA = (const char*)g.A + (GATHER ? (size_t)0 : (size_t)cur.pm * tstepA); const char* cB = (const char*)g.Bt + (size_t)cur.e * g.bstrideE + (size_t)cur.pn * tstepB;
    PG8_STAGE(PG8_SB(0, 0), cB, voffB); PG8_STAGE(PG8_SB(0, 1), cB + hstepB, voffB); XSTA(PG8_SA(0, 0), cA, 0, 0); XSTA(PG8_SA(0, 1), cA, 0, 1);
    if (wr == 1) PG8_BAR;
    PG8_WAIT_V(2); PG8_BAR;
    PG8_STAGE(PG8_SB(1, 0), cB + kstep, voffB); XSTA(PG8_SA(1, 0), cA + kstep, 0, 0); PG8_STAGE(PG8_SB(1, 1), cB + hstepB + kstep, voffB);
    PG8_WAIT_V(6); PG8_BAR;
    for (;;) {
        const bool has_next = S.next(ui + 1, nxt);
        const char* nA = (has_next && !GATHER) ? (const char*)g.A + (size_t)nxt.pm * tstepA : cA;
        const char* nB = has_next ? (const char*)g.Bt + (size_t)nxt.e * g.bstrideE + (size_t)nxt.pn * tstepB : cB;
#define PG8_KBODY(t) do { \
            const bool last = (t == nt - 2); const int u2 = (last && has_next) ? ui + 1 : ui; \
            const char* a1 = cA + (size_t)(t + 1) * kstep; \
            const char* a2 = last ? (GATHER ? (const char*)g.A : nA) : cA + (size_t)(t + 2) * kstep; const char* b2 = last ? nB : cB + (size_t)(t + 2) * kstep; \
            const char* a3 = a2 + kstep; const char* b3 = b2 + kstep; \
            XSTA(PG8_SA(1, 1), a1, ui, 1); XLDB0(0, 0); XLDB1(0, 1); PG8_SCHED; XLDA(0, 0); \
            PG8_WAIT_V(8); PG8_WAIT_L(0); PG8_BAR; XMMA0(0, 0); XMMA1(0, 1); PG8_BAR; PG8_SCHED; \
            PG8_STAGE(PG8_SB(0, 0), b2, voffB); PG8_STAGE(PG8_SB(0, 1), b2 + hstepB, voffB); XSTA(PG8_SA(0, 0), a2, u2, 0); XLDA(0, 1); \
            PG8_WAIT_V(8); PG8_WAIT_L(0); PG8_BAR; XMMA0(1, 0); XMMA1(1, 1); PG8_BAR; PG8_SCHED; \
            XSTA(PG8_SA(0, 1), a2, u2, 1); XLDB0(1, 0); XLDB1(1, 1); PG8_SCHED; XLDA(1, 0); \
            PG8_WAIT_V(8); PG8_WAIT_L(0); PG8_BAR; XMMA0(0, 0); XMMA1(0, 1); PG8_BAR; PG8_SCHED; \
            PG8_STAGE(PG8_SB(1, 0), b3, voffB); PG8_STAGE(PG8_SB(1, 1), b3 + hstepB, voffB); XSTA(PG8_SA(1, 0), a3, u2, 0); XLDA(1, 1); \
            PG8_WAIT_V(8); PG8_WAIT_L(0); PG8_BAR; XMMA0(1, 0); XMMA1(1, 1); PG8_BAR; PG8_SCHED; \
        } while (0)
        if constexpr (Epi::HAS_MID) {
#pragma nounroll
            for (int t = 0; t < Epi::MID_T; t += 2) PG8_KBODY(t);
            E.mid(acc, cur, wr, wc, fr, fq);
#pragma nounroll
            for (int t = Epi::MID_T; t < nt; t += 2) PG8_KBODY(t);
        } else {
#pragma nounroll
            for (int t = 0; t < nt; t += 2) PG8_KBODY(t);
        }
        if constexpr (ALIGN_EPI) { if (wr == 0) PG8_BAR; }
        {
            const int l2 = lane_id_here();
            cur.last = has_next ? 0 : 1;
            E(acc, cur, wid >> 2, wid & 3, l2 & 15, l2 >> 4);
        }
        if (!has_next) break;
#pragma unroll
        for (int a = 0; a < 2; ++a)
#pragma unroll
            for (int b = 0; b < 2; ++b)
#pragma unroll
                for (int m = 0; m < 4; ++m)
#pragma unroll
                    for (int n = 0; n < 2; ++n) acc[a][b][m][n] = (f32x4){0.f, 0.f, 0.f, 0.f};
        cur = nxt; cA = nA; cB = nB; ++ui;
        if constexpr (ALIGN_EPI) { if (wr == 1) PG8_BAR; }
    }
    PG8_WAIT_V(0);
    if constexpr (!ALIGN_EPI) { if (wr == 0) PG8_BAR; }
    PG8_BAR;
#undef PG8_SA
#undef PG8_SB
#undef PG8_STAGE
#undef PG8_KBODY
#undef XSTA
#undef PG8_LDA
#undef PG8_LDB
#undef PG8_MMA16
#undef PG8_MMA8
#undef PG8_LDA8
#undef PG8_LDB8
#undef XLDA
#undef XLDB0
#undef XLDB1
#undef XMMA0
#undef XMMA1
#undef PG8_WAIT_V
#undef PG8_WAIT_L
#undef PG8_BAR
#undef PG8_SCHED
}

__device__ __forceinline__ u32x4 pack8(const f32x4 v0, const f32x4 v1) { u32x4 w; w.x = cvt_pk_bf16(v0[0], v0[1]); w.y = cvt_pk_bf16(v0[2], v0[3]); w.z = cvt_pk_bf16(v1[0], v1[1]); w.w = cvt_pk_bf16(v1[2], v1[3]); return w; }
__device__ __forceinline__ void unpack8(const u32x4 w, f32x4& v0, f32x4& v1) { v0 = (f32x4){bflo(w.x), bfhi(w.x), bflo(w.y), bfhi(w.y)}; v1 = (f32x4){bflo(w.z), bfhi(w.z), bflo(w.w), bfhi(w.w)}; }

struct EpiU { static constexpr bool HAS_MID = false; static constexpr bool PERM = true; bf16_t* U; float sc;
    __device__ __forceinline__ void operator()(const Acc& acc, const Unit& u, int wr, int wc, int fr, int fq) const {
        const int row0 = u.pm * BM + wr * 64 + fr, col0 = u.pn * BM + wc * 32 + 8 * fq;
        const int mode = u.pn < 2 ? 1 : (u.pn >= 5 ? 2 : 0);
        const float s1 = mode == 1 ? 0.125f * sc : sc;
#pragma unroll
        for (int ai = 0; ai < 2; ++ai)
#pragma unroll
            for (int m = 0; m < 4; ++m) { bf16_t* rowp = U + (size_t)(row0 + ai * HALF + m * 16) * INW + col0;
#pragma unroll
                for (int bj = 0; bj < 2; ++bj) { f32x4 v0, v1;
                    if (mode == 2) {
                        const float ks = -1.4426950408889634f * s1; const f32x2 k2 = (f32x2){ks, ks}, one2 = (f32x2){1.0f, 1.0f};
#pragma unroll
                        for (int hq = 0; hq < 2; ++hq) { const f32x4 av = acc[ai][bj][m][hq]; f32x4 rv;
#pragma unroll
                            for (int jp = 0; jp < 2; ++jp) { const f32x2 ea = (f32x2){av[2 * jp], av[2 * jp + 1]} * k2;
                                const f32x2 d = (f32x2){__builtin_amdgcn_exp2f(fminf(ea[0], 57.0f)), __builtin_amdgcn_exp2f(fminf(ea[1], 57.0f))} + one2;
                                const float r = __builtin_amdgcn_rcpf(d[0] * d[1]);
                                const f32x2 sg = (f32x2){d[1], d[0]} * (f32x2){r, r}; rv[2 * jp] = sg[0]; rv[2 * jp + 1] = sg[1]; }
                            if (hq == 0) v0 = rv; else v1 = rv; }
                    } else { v0 = acc[ai][bj][m][0] * s1; v1 = acc[ai][bj][m][1] * s1; }
                    *(u32x4*)(rowp + bj * HALF) = pack8(v0, v1); } }
    } };
struct EpiBrA { static constexpr bool HAS_MID = false; static constexpr bool PERM = true; const bf16_t* U; float* T;
    __device__ __forceinline__ void operator()(const Acc& acc, const Unit& u, int wr, int wc, int fr, int fq) const {
        const int row0 = u.pm * BM + wr * 64 + fr, col0 = u.pn * BM + wc * 32 + 8 * fq;
#pragma unroll
        for (int ai = 0; ai < 2; ++ai)
#pragma unroll
            for (int m = 0; m < 4; ++m) { const size_t row = (size_t)(row0 + ai * HALF + m * 16);
#pragma unroll
                for (int bj = 0; bj < 2; ++bj) { const int col = col0 + bj * HALF; f32x4 g0, g1; unpack8(*(const u32x4*)(U + row * INW + OGA + col), g0, g1);
                    float* tp = T + row * DM + col; *(f32x4*)tp = g0 * acc[ai][bj][m][0]; *(f32x4*)(tp + 4) = g1 * acc[ai][bj][m][1]; } }
    } };
struct EpiBrP { static constexpr bool HAS_MID = false; static constexpr bool PERM = true; const bf16_t* U; const float* T; bf16_t* MIX;
    __device__ __forceinline__ void operator()(const Acc& acc, const Unit& u, int wr, int wc, int fr, int fq) const {
        const int row0 = u.pm * BM + wr * 64 + fr, col0 = u.pn * BM + wc * 32 + 8 * fq;
#pragma unroll
        for (int ai = 0; ai < 2; ++ai)
#pragma unroll
            for (int m = 0; m < 4; ++m) { const size_t row = (size_t)(row0 + ai * HALF + m * 16);
#pragma unroll
                for (int bj = 0; bj < 2; ++bj) { const int col = col0 + bj * HALF; f32x4 g0, g1; unpack8(*(const u32x4*)(U + row * INW + OGP + col), g0, g1);
                    const float* tp = T + row * DM + col; const f32x4 t0 = *(const f32x4*)tp, t1 = *(const f32x4*)(tp + 4);
                    *(u32x4*)(MIX + row * DM + col) = pack8(t0 + g0 * acc[ai][bj][m][0], t1 + g1 * acc[ai][bj][m][1]); } }
    } };
struct EpiMix { static constexpr bool HAS_MID = true; static constexpr int MID_T = 8; static constexpr bool PERM = true; const bf16_t* U; bf16_t* MIX;
    __device__ __forceinline__ void mid(Acc& acc, const Unit& u, int wr, int wc, int fr, int fq) const {
        const int row0 = u.pm * BM + wr * 64 + fr, col0 = u.pn * BM + wc * 32 + 8 * fq;
#pragma unroll
        for (int ai = 0; ai < 2; ++ai)
#pragma unroll
            for (int m = 0; m < 4; ++m) { const bf16_t* up = U + (size_t)(row0 + ai * HALF + m * 16) * INW + col0;
#pragma unroll
                for (int bj = 0; bj < 2; ++bj) { f32x4 a0, a1, p0, p1; unpack8(*(const u32x4*)(up + OGA + bj * HALF), a0, a1); unpack8(*(const u32x4*)(up + OGP + bj * HALF), p0, p1);
#pragma unroll
                    for (int hq = 0; hq < 2; ++hq) { const f32x4 av = hq ? a1 : a0, pv = hq ? p1 : p0;
#pragma unroll
                        for (int jp = 0; jp < 2; ++jp) { const f32x2 pp = (f32x2){fmaxf(pv[2 * jp], 1e-18f), fmaxf(pv[2 * jp + 1], 1e-18f)};
                            const float r = __builtin_amdgcn_rcpf(pp[0] * pp[1]);
                            const f32x2 f = (f32x2){av[2 * jp], av[2 * jp + 1]} * ((f32x2){pp[1], pp[0]} * (f32x2){r, r});
                            acc[ai][bj][m][hq][2 * jp] *= f[0]; acc[ai][bj][m][hq][2 * jp + 1] *= f[1]; } } } }
    }
    __device__ __forceinline__ void operator()(const Acc& acc, const Unit& u, int wr, int wc, int fr, int fq) const {
        const int row0 = u.pm * BM + wr * 64 + fr, col0 = u.pn * BM + wc * 32 + 8 * fq;
#pragma unroll
        for (int ai = 0; ai < 2; ++ai)
#pragma unroll
            for (int m = 0; m < 4; ++m) { const size_t row = (size_t)(row0 + ai * HALF + m * 16);
#pragma unroll
                for (int bj = 0; bj < 2; ++bj) { const int col = col0 + bj * HALF; f32x4 p0, p1; unpack8(*(const u32x4*)(U + row * INW + OGP + col), p0, p1);
#pragma unroll
                    for (int j = 0; j < 4; ++j) { p0[j] = fmaxf(p0[j], 1e-18f); p1[j] = fmaxf(p1[j], 1e-18f); }
                    const f32x4 m0 = p0 * acc[ai][bj][m][0] * MSC, m1 = p1 * acc[ai][bj][m][1] * MSC; u32x2 o; o.x = pk4_fp8(m0[0], m0[1], m0[2], m0[3]); o.y = pk4_fp8(m1[0], m1[1], m1[2], m1[3]);
                    *(u32x2*)((unsigned char*)MIX + row * DM + col) = o; } }
    } };
struct EpiZ { static constexpr bool HAS_MID = false; static constexpr bool PERM = true; const bf16_t* XB; bf16_t* Z; float sc;
    __device__ __forceinline__ void operator()(const Acc& acc, const Unit& u, int wr, int wc, int fr, int fq) const {
        const int row0 = u.pm * BM + wr * 64 + fr, col0 = u.pn * BM + wc * 32 + 8 * fq;
#pragma unroll
        for (int ai = 0; ai < 2; ++ai)
#pragma unroll
            for (int m = 0; m < 4; ++m) { const size_t off = (size_t)(row0 + ai * HALF + m * 16) * DM + col0;
#pragma unroll
                for (int bj = 0; bj < 2; ++bj) { f32x4 x0, x1; unpack8(*(const u32x4*)(XB + off + bj * HALF), x0, x1);
                    *(u32x4*)(Z + off + bj * HALF) = pack8(x0 * ALPHA + acc[ai][bj][m][0] * sc, x1 * ALPHA + acc[ai][bj][m][1] * sc); } }
    } };
struct EpiAct { static constexpr bool HAS_MID = false; static constexpr bool PERM = true; const LAS bf16_t* bl; unsigned char* ACT;
    __device__ __forceinline__ void operator()(const Acc& acc, const Unit& u, int wr, int wc, int fr, int fq) const {
        const int row0 = u.pm * BM + wr * 64 + fr, j0 = u.pn * HALF + wc * 32 + 8 * fq;
        const LAS bf16_t* bp = bl + u.ord * 256 + wc * 32 + 8 * fq;
        f32x4 bg0, bg1, bu0, bu1; unpack8(*(const LAS u32x4*)bp, bg0, bg1); unpack8(*(const LAS u32x4*)(bp + 128), bu0, bu1);
        const f32x2 ws = (f32x2){WSC_INV, WSC_INV}, one2 = (f32x2){1.0f, 1.0f}, k2 = (f32x2){-1.702f * 1.4426950408889634f, -1.702f * 1.4426950408889634f};
#pragma unroll
        for (int ai = 0; ai < 2; ++ai)
#pragma unroll
            for (int m = 0; m < 4; ++m) {
                f32x4 o[2];
#pragma unroll
                for (int n = 0; n < 2; ++n) { const f32x4 ag = acc[ai][0][m][n], au = acc[ai][1][m][n], bgv = n ? bg1 : bg0, buv = n ? bu1 : bu0;
#pragma unroll
                    for (int jp = 0; jp < 2; ++jp) {
                        const f32x2 hg = (f32x2){ag[2 * jp], ag[2 * jp + 1]} * ws + (f32x2){bgv[2 * jp], bgv[2 * jp + 1]}, hu = (f32x2){au[2 * jp], au[2 * jp + 1]} * ws + (f32x2){buv[2 * jp], buv[2 * jp + 1]};
                        const f32x2 gate = (f32x2){__builtin_amdgcn_fmed3f(hg[0], -20.0f, 7.0f), __builtin_amdgcn_fmed3f(hg[1], -20.0f, 7.0f)}, up = (f32x2){__builtin_amdgcn_fmed3f(hu[0], -7.0f, 7.0f), __builtin_amdgcn_fmed3f(hu[1], -7.0f, 7.0f)};
                        const f32x2 t = (up + one2) * gate, ea = gate * k2;
                        const f32x2 d = (f32x2){__builtin_amdgcn_exp2f(ea[0]), __builtin_amdgcn_exp2f(ea[1])} + one2;
                        const float r = __builtin_amdgcn_rcpf(d[0] * d[1]);
                        const f32x2 res = t * ((f32x2){d[1], d[0]} * (f32x2){r, r});
                        o[n][2 * jp] = res[0]; o[n][2 * jp + 1] = res[1]; } }
                u32x2 w8; w8.x = pk4_fp8(o[0][0], o[0][1], o[0][2], o[0][3]); w8.y = pk4_fp8(o[1][0], o[1][1], o[1][2], o[1][3]);
                *(u32x2*)(ACT + (size_t)(row0 + ai * HALF + m * 16) * DE + j0) = w8; }
    } };
struct EpiY { static constexpr bool HAS_MID = false; static constexpr bool PERM = true; const LAS float* bl; bf16_t* YB;
    __device__ __forceinline__ void operator()(const Acc& acc, const Unit& u, int wr, int wc, int fr, int fq) const {
        const int row0 = u.pm * BM + wr * 64 + fr, col0 = u.pn * BM + wc * 32 + 8 * fq;
        const LAS float* bp = bl + u.ord * 256 + wc * 32 + 8 * fq;
        f32x4 bv[2][2];
#pragma unroll
        for (int bj = 0; bj < 2; ++bj) { bv[bj][0] = *(const LAS f32x4*)(bp + bj * HALF); bv[bj][1] = *(const LAS f32x4*)(bp + bj * HALF + 4); }
#pragma unroll
        for (int ai = 0; ai < 2; ++ai)
#pragma unroll
            for (int m = 0; m < 4; ++m) { bf16_t* rowp = YB + (size_t)(row0 + ai * HALF + m * 16) * DM + col0;
#pragma unroll
                for (int bj = 0; bj < 2; ++bj) { const u32x4 o = pack8(acc[ai][bj][m][0] * WSC_INV + bv[bj][0], acc[ai][bj][m][1] * WSC_INV + bv[bj][1]);
                    if (u.last) { if (bj == 0) asm volatile("s_nop 0\n\tglobal_store_dwordx4 %0, %1, off sc1\n\ts_nop 2" :: "v"(rowp), "v"(o) : "memory"); else asm volatile("s_nop 0\n\tglobal_store_dwordx4 %0, %1, off offset:256 sc1\n\ts_nop 2" :: "v"(rowp), "v"(o) : "memory"); }
                    else *(u32x4*)(rowp + bj * HALF) = o; } }
    } };
}

template <bool NT, bool F8 = false>
__device__ __forceinline__ void p0_item(const float* W, int N, int k0, int n0, bf16_t* WT, int ldt, int drow0, int dk0, LAS float* scr, int lane) {
    const int kr = lane >> 3, n4 = (lane & 7) * 4;
    f32x4 v[8];
#pragma unroll
    for (int i = 0; i < 8; ++i) { const f32x4* p = (const f32x4*)(W + (size_t)(k0 + 8 * i + kr) * N + n0 + n4); v[i] = NT ? __builtin_nontemporal_load(p) : *p; }
#pragma unroll
    for (int i = 0; i < 8; ++i) { LAS float* d = scr + (8 * i + kr) * 33 + n4; d[0] = v[i][0]; d[1] = v[i][1]; d[2] = v[i][2]; d[3] = v[i][3]; }
    asm volatile("s_waitcnt lgkmcnt(0)" ::: "memory");
    const int c = lane & 7;
#pragma unroll
    for (int j = 0; j < 4; ++j) { const int n = (lane >> 3) + 8 * j; const LAS float* s = scr + (8 * c) * 33 + n;
        if constexpr (F8) { u32x2 o; o.x = pk4_fp8(s[0 * 33] * WSC, s[1 * 33] * WSC, s[2 * 33] * WSC, s[3 * 33] * WSC); o.y = pk4_fp8(s[4 * 33] * WSC, s[5 * 33] * WSC, s[6 * 33] * WSC, s[7 * 33] * WSC);
            *(u32x2*)((unsigned char*)WT + (size_t)(drow0 + n) * ldt + dk0 + k0 + 8 * c) = o; }
        else { u32x4 o; o.x = cvt_pk_bf16(s[0 * 33], s[1 * 33]); o.y = cvt_pk_bf16(s[2 * 33], s[3 * 33]); o.z = cvt_pk_bf16(s[4 * 33], s[5 * 33]); o.w = cvt_pk_bf16(s[6 * 33], s[7 * 33]);
            *(u32x4*)(WT + (size_t)(drow0 + n) * ldt + dk0 + k0 + 8 * c) = o; } }
    asm volatile("s_waitcnt lgkmcnt(0)" ::: "memory");
}
constexpr int CONV_I1 = NE * (DM / 64) * (2 * DE / 32), CONV_I2 = NE * (DE / 64) * (DM / 32);
struct ConvItem { const float* W; unsigned char* WT; int N, ldt, k0, n0, drow; };
__device__ __forceinline__ void conv_load(f32x4 (&v)[8], const ConvItem& it, int lane) {
    const int kr = lane >> 3, n4 = (lane & 7) * 4;
#pragma unroll
    for (int i = 0; i < 8; ++i) v[i] = __builtin_nontemporal_load((const f32x4*)(it.W + (size_t)(it.k0 + 8 * i + kr) * it.N + it.n0 + n4));
}
__device__ __forceinline__ void conv_finish(const f32x4 (&v)[8], const ConvItem& it, LAS float* scr, int lane) {
    const int kr = lane >> 3, n4 = (lane & 7) * 4;
#pragma unroll
    for (int i = 0; i < 8; ++i) { LAS float* d = scr + (8 * i + kr) * 33 + n4; d[0] = v[i][0]; d[1] = v[i][1]; d[2] = v[i][2]; d[3] = v[i][3]; }
    asm volatile("s_waitcnt lgkmcnt(0)" ::: "memory");
    const int c = lane & 7;
#pragma unroll
    for (int j = 0; j < 4; ++j) { const int n = (lane >> 3) + 8 * j; const LAS float* sp = scr + (8 * c) * 33 + n;
        u32x2 o; o.x = pk4_fp8(sp[0 * 33] * WSC, sp[1 * 33] * WSC, sp[2 * 33] * WSC, sp[3 * 33] * WSC); o.y = pk4_fp8(sp[4 * 33] * WSC, sp[5 * 33] * WSC, sp[6 * 33] * WSC, sp[7 * 33] * WSC);
        *(u32x2*)(it.WT + (size_t)(it.drow + n) * it.ldt + it.k0 + 8 * c) = o; }
    asm volatile("s_waitcnt lgkmcnt(0)" ::: "memory");
}
__device__ __forceinline__ ConvItem w1_item(const float* w1, bf16_t* W1t, int r) {
    constexpr int I_1 = (DM / 64) * (2 * DE / 32), KB = DM / 64;
    const int e = r / I_1, q = r % I_1, n0 = 32 * (q / KB), k0 = 64 * (q % KB);
    const int drow = n0 < DE ? 256 * (n0 >> 7) + (n0 & 127) : 256 * ((n0 - DE) >> 7) + 128 + ((n0 - DE) & 127);
    return ConvItem{w1 + (size_t)e * DM * 2 * DE, (unsigned char*)W1t + (size_t)e * 2 * DE * DM, 2 * DE, DM, k0, n0, drow};
}
__device__ __forceinline__ ConvItem w2_item(const float* w2, bf16_t* W2t, int r) {
    constexpr int I_2 = (DE / 64) * (DM / 32), KB = DE / 64;
    const int e = r / I_2, q = r % I_2, n0 = 32 * (q / KB), k0 = 64 * (q % KB);
    return ConvItem{w2 + (size_t)e * DE * DM, (unsigned char*)W2t + (size_t)e * DM * DE, DM, DE, k0, n0, n0};
}
template <int WHICH>
__device__ __forceinline__ void conv_w(const float* w, bf16_t* Wt, LAS float* scr, int first, int last, int worker, int nworkers, int lane) {
    int p = (first >> 1) + worker; const int pe = last >> 1;
    if (p >= pe) return;
    f32x4 r0[8], r1[8];
    ConvItem i0 = WHICH == 1 ? w1_item(w, Wt, 2 * p) : w2_item(w, Wt, 2 * p), i1 = WHICH == 1 ? w1_item(w, Wt, 2 * p + 1) : w2_item(w, Wt, 2 * p + 1);
    conv_load(r0, i0, lane); conv_load(r1, i1, lane);
    for (;;) {
        const int pn = p + nworkers; const bool more = pn < pe;
        conv_finish(r0, i0, scr, lane);
        if (more) { i0 = WHICH == 1 ? w1_item(w, Wt, 2 * pn) : w2_item(w, Wt, 2 * pn); conv_load(r0, i0, lane); }
        conv_finish(r1, i1, scr, lane);
        if (!more) break;
        i1 = WHICH == 1 ? w1_item(w, Wt, 2 * pn + 1) : w2_item(w, Wt, 2 * pn + 1); conv_load(r1, i1, lane);
        p = pn;
    }
}
__device__ __forceinline__ void conv_w1(const float* w1, bf16_t* W1t, LAS float* scr, int first, int last, int worker, int nworkers, int lane) { conv_w<1>(w1, W1t, scr, first, last, worker, nworkers, lane); }
__device__ __forceinline__ void conv_w2(const float* w2, bf16_t* W2t, LAS float* scr, int first, int last, int worker, int nworkers, int lane) { conv_w<2>(w2, W2t, scr, first, last, worker, nworkers, lane); }
__device__ __forceinline__ void conv_w1_dyn(const float* w, bf16_t* Wt, LAS float* scr, unsigned* pool_ctr, int base, int stride, int nstat, int dyn_base, int dyn_n, int lane) {
    int is = 0;
    auto next = [&]() -> int {
        if (is < nstat) return base + stride * is++;
        unsigned t = 0u; if (lane == 0) t = __hip_atomic_fetch_add(pool_ctr, 1u, __ATOMIC_RELAXED, __HIP_MEMORY_SCOPE_AGENT);
        t = (unsigned)__builtin_amdgcn_readfirstlane((int)t); return (int)t < dyn_n ? dyn_base + (int)t : -1; };
    int p = next();
    if (p < 0) return;
    f32x4 r0[8], r1[8];
    ConvItem i0 = w1_item(w, Wt, 2 * p), i1 = w1_item(w, Wt, 2 * p + 1);
    conv_load(r0, i0, lane); conv_load(r1, i1, lane);
    for (;;) {
        const int pn = next(); const bool more = pn >= 0;
        conv_finish(r0, i0, scr, lane);
        if (more) { i0 = w1_item(w, Wt, 2 * pn); conv_load(r0, i0, lane); }
        conv_finish(r1, i1, scr, lane);
        if (!more) break;
        i1 = w1_item(w, Wt, 2 * pn + 1); conv_load(r1, i1, lane);
        p = pn;
    }
}

constexpr int PL_STRIDE = 272, PL_YS_OFF = 144 * PL_STRIDE, PL_WS_OFF = PL_YS_OFF + 128 * PL_STRIDE;
struct PoolRegs { u32x4 p[2][5]; };
__device__ __forceinline__ void pool_fetch(PoolRegs& pr, const bf16_t* __restrict__ U, const bf16_t* __restrict__ Wgt, int pair, int tid) {
    (void)Wgt;
    constexpr int NPU_ = (NTOK / 128) * 4;
#pragma unroll
    for (int w = 0; w < 2; ++w) { const int unit = w ? NPU_ - 1 - pair : pair;
        const int g = unit & 3, tt = unit >> 2, tok0 = tt * 128, b = tok0 / SEQ, t0 = tok0 % SEQ;
#pragma unroll
        for (int j = 0; j < 5; ++j) { const int p = tid + 512 * j, lr = p >> 4, c8 = p & 15, t = t0 - 8 + lr; pr.p[w][j] = (u32x4){0u, 0u, 0u, 0u};
            if (p < 144 * 16 && t >= 0 && t < SEQ) pr.p[w][j] = *(const u32x4*)(U + (size_t)(b * SEQ + t) * INW + OP + 128 * g + 8 * c8); } }
}
__device__ __forceinline__ void pool_put(const PoolRegs& pr, LAS unsigned char* lds, int tid) {
#pragma unroll
    for (int w = 0; w < 2; ++w) { LAS unsigned char* Ps = lds + w * PL_YS_OFF;
#pragma unroll
        for (int j = 0; j < 5; ++j) { const int p = tid + 512 * j, lr = p >> 4, c8 = p & 15; if (p < 144 * 16) *(LAS u32x4*)(Ps + lr * PL_STRIDE + c8 * 16) = pr.p[w][j]; } }
}
__device__ __forceinline__ int crow(int r, int hi) { return (r & 3) + 8 * (r >> 2) + 4 * hi; }
constexpr int KS_STRIDE = 144, VT_STRIDE = 776, ATT_VT_OFF = 384 * KS_STRIDE, ATT_SC_OFF = ATT_VT_OFF + 64 * VT_STRIDE;
template <bool PF>
__device__ __forceinline__ void attn_unit(LAS unsigned char* lds, const bf16_t* __restrict__ U, const float* __restrict__ sinks, bf16_t* __restrict__ AY, int unit, int tid, int wave, int lane, PoolRegs& pr, const bf16_t* __restrict__ Wgt, int next_pool) {
    const int kvh = unit & 1, blk = (unit >> 1) & 63, b = unit >> 7;
    const int tok0 = b * SEQ + blk * 128;
    LAS unsigned char* Ks = lds; LAS unsigned char* Vt = lds + ATT_VT_OFF; LAS float* lsc = (LAS float*)(lds + ATT_SC_OFF) + wave * 64;
    const int g = wave >> 1, qh = wave & 1, h = 4 * kvh + g, l31 = lane & 31, hh = lane >> 5;
    const float slope = exp2f(-(float)(h + 1)), sink = sinks[h];
    bf16x8 qf[2][4];
#pragma unroll
    for (int qb = 0; qb < 2; ++qb)
#pragma unroll
        for (int s4 = 0; s4 < 4; ++s4) qf[qb][s4] = *(const bf16x8*)(U + (size_t)(tok0 + 64 * qh + 32 * qb + l31) * INW + OQ + h * 64 + 16 * s4 + 8 * hh);
    float kn2 = 0.f;
    u32x4 kreg[6], vreg[3][2];
#pragma unroll
    for (int j = 0; j < 6; ++j) { const int p = tid + 512 * j, row = p >> 3, c8 = p & 7, kb = blk - 1 + (row >> 7); kreg[j] = (u32x4){0u, 0u, 0u, 0u};
        if (kb >= 0 && kb < SEQ / 128) kreg[j] = *(const u32x4*)(U + (size_t)(b * SEQ + kb * 128 + (row & 127)) * INW + OKK + kvh * 64 + 8 * c8); }
#pragma unroll
    for (int j = 0; j < 3; ++j) { const int pp = tid + 512 * j, kp = pp >> 3, dc = pp & 7, row = 2 * kp, kb = blk - 1 + (row >> 7); vreg[j][0] = (u32x4){0u, 0u, 0u, 0u}; vreg[j][1] = vreg[j][0];
        if (kb >= 0 && kb < SEQ / 128) { const bf16_t* src = U + (size_t)(b * SEQ + kb * 128 + (row & 127)) * INW + OV + kvh * 64 + 8 * dc; vreg[j][0] = *(const u32x4*)src; vreg[j][1] = *(const u32x4*)(src + INW); } }
#pragma unroll
    for (int j = 0; j < 6; ++j) { const int p = tid + 512 * j, row = p >> 3, c8 = p & 7; const u32x4 v = kreg[j];
        *(LAS u32x4*)(Ks + row * KS_STRIDE + c8 * 16) = v;
        f32x4 k0, k1; pg8::unpack8(v, k0, k1);
        float ss = (k0[0] * k0[0] + k0[1] * k0[1]) + (k0[2] * k0[2] + k0[3] * k0[3]) + (k1[0] * k1[0] + k1[1] * k1[1]) + (k1[2] * k1[2] + k1[3] * k1[3]);
        ss += dppf<0xB1>(ss); ss += dppf<0x4E>(ss); ss += dppf<0x141>(ss);
        kn2 = fmaxf(kn2, ss);
    }
    kn2 = fmaxf(kn2, __shfl_xor(kn2, 8)); kn2 = fmaxf(kn2, __shfl_xor(kn2, 16)); kn2 = fmaxf(kn2, __shfl_xor(kn2, 32));
    LAS float* knw = (LAS float*)(lds + ATT_SC_OFF + 2048);
    if (lane == 0) knw[wave] = kn2;
#pragma unroll
    for (int j = 0; j < 3; ++j) { const int pp = tid + 512 * j, kp = pp >> 3, dc = pp & 7; const u32x4 v0 = vreg[j][0], v1 = vreg[j][1];
        LAS unsigned char* dst = Vt + (8 * dc) * VT_STRIDE + kp * 4;
#pragma unroll
        for (int i = 0; i < 4; ++i) {
            const unsigned w0 = v0[i], w1 = v1[i];
            *(LAS unsigned*)(dst + (2 * i) * VT_STRIDE) = (w0 & 0xffffu) | (w1 << 16);
            *(LAS unsigned*)(dst + (2 * i + 1) * VT_STRIDE) = (w0 >> 16) | (w1 & 0xffff0000u);
        }
    }
    __syncthreads();
    const int kt0 = max(qh ? 2 : 0, blk == 0 ? 4 : 0), kt1 = min(qh ? 12 : 10, blk == SEQ / 128 - 1 ? 8 : 12);
    const float nslope = -slope;
    float mx[2];
    { const float kmax2 = fmaxf(fmaxf(fmaxf(knw[0], knw[1]), fmaxf(knw[2], knw[3])), fmaxf(fmaxf(knw[4], knw[5]), fmaxf(knw[6], knw[7])));
#pragma unroll
      for (int qb = 0; qb < 2; ++qb) { float qs = 0.f;
#pragma unroll
          for (int s4 = 0; s4 < 4; ++s4) { f32x4 q0, q1; pg8::unpack8(__builtin_bit_cast(u32x4, qf[qb][s4]), q0, q1);
              qs += (q0[0] * q0[0] + q0[1] * q0[1]) + (q0[2] * q0[2] + q0[3] * q0[3]) + (q1[0] * q1[0] + q1[1] * q1[1]) + (q1[2] * q1[2] + q1[3] * q1[3]); }
          qs += __shfl_xor(qs, 32);
          mx[qb] = fmaxf(sink, sqrtf(qs * kmax2)); } }
    const float L2E = 1.4426950408889634f;
    float lsum[2] = {0.f, 0.f};
    f32x16 o[2][2];
#pragma unroll
    for (int qb = 0; qb < 2; ++qb)
#pragma unroll
        for (int db = 0; db < 2; ++db)
#pragma unroll
            for (int r = 0; r < 16; ++r) o[qb][db][r] = 0.f;
    for (int kt = kt0; kt < kt1; ++kt) {
        bf16x8 kf[4];
#pragma unroll
        for (int s4 = 0; s4 < 4; ++s4) kf[s4] = *(const LAS bf16x8*)(Ks + (kt * 32 + l31) * KS_STRIDE + (16 * s4 + 8 * hh) * 2);
        bf16x8 vf[2][2];
#pragma unroll
        for (int db = 0; db < 2; ++db)
#pragma unroll
            for (int s2 = 0; s2 < 2; ++s2) {
                const LAS unsigned char* vp = Vt + (32 * db + l31) * VT_STRIDE + (kt * 32 + 16 * s2 + 4 * hh) * 2;
                const u32x2 lo = *(const LAS u32x2*)vp, hi2 = *(const LAS u32x2*)(vp + 16);
                u32x4 w = (u32x4){lo.x, lo.y, hi2.x, hi2.y}; vf[db][s2] = __builtin_bit_cast(bf16x8, w);
            }
#pragma unroll
        for (int qb = 0; qb < 2; ++qb) {
            f32x16 sa;
#pragma unroll
            for (int r = 0; r < 16; ++r) sa[r] = 0.f;
#pragma unroll
            for (int s4 = 0; s4 < 4; ++s4) sa = __builtin_amdgcn_mfma_f32_32x32x16_bf16(kf[s4], qf[qb][s4], sa, 0, 0, 0);
            const float relb = (float)(kt * 32 + 4 * hh - 128 - (64 * qh + 32 * qb + l31)); const float mq = mx[qb] * L2E, ns2 = nslope * L2E;
            const int tk = kt - 4, sub = 2 * qh + qb;
            const f32x2 relb2 = (f32x2){relb, relb + 1.0f}, l2e2 = (f32x2){L2E, L2E}, nmq2 = (f32x2){-mq, -mq};
            f32x2 ls2 = (f32x2){0.f, 0.f};
            if (tk == sub) {
                const f32x2 ns22 = (f32x2){ns2, ns2};
#pragma unroll
                for (int rp = 0; rp < 8; ++rp) { const float c = (float)(((2 * rp) & 3) + 8 * ((2 * rp) >> 2)); const f32x2 x2 = relb2 + (f32x2){c, c};
                    const f32x2 a2 = (f32x2){sa[2 * rp], sa[2 * rp + 1]} * l2e2 + ((f32x2){fabsf(x2[0]), fabsf(x2[1])} * ns22 + nmq2);
                    const f32x2 pe = (f32x2){__builtin_amdgcn_exp2f(a2[0]), __builtin_amdgcn_exp2f(a2[1])}; sa[2 * rp] = pe[0]; sa[2 * rp + 1] = pe[1]; ls2 = ls2 + pe; }
            } else {
                const bool left = tk < sub; const float sg = left ? -ns2 : ns2; const f32x2 sg2 = (f32x2){sg, sg};
                if ((kt >= 4) && (kt < 8)) {
#pragma unroll
                    for (int rp = 0; rp < 8; ++rp) { const float c = (float)(((2 * rp) & 3) + 8 * ((2 * rp) >> 2)); const f32x2 x2 = relb2 + (f32x2){c, c};
                        const f32x2 a2 = (f32x2){sa[2 * rp], sa[2 * rp + 1]} * l2e2 + (x2 * sg2 + nmq2);
                        const f32x2 pe = (f32x2){__builtin_amdgcn_exp2f(a2[0]), __builtin_amdgcn_exp2f(a2[1])}; sa[2 * rp] = pe[0]; sa[2 * rp + 1] = pe[1]; ls2 = ls2 + pe; }
                } else {
                    const float lim = left ? 128.0f : -128.0f;
#pragma unroll
                    for (int rp = 0; rp < 8; ++rp) { const float c = (float)(((2 * rp) & 3) + 8 * ((2 * rp) >> 2)); const f32x2 x2 = relb2 + (f32x2){c, c};
                        const f32x2 a2 = (f32x2){sa[2 * rp], sa[2 * rp + 1]} * l2e2 + (x2 * sg2 + nmq2);
                        f32x2 pe = (f32x2){__builtin_amdgcn_exp2f(a2[0]), __builtin_amdgcn_exp2f(a2[1])};
                        const bool k0 = left ? (-x2[0] <= lim) : (-x2[0] >= lim), k1 = left ? (-x2[1] <= lim) : (-x2[1] >= lim);
                        pe[0] = k0 ? pe[0] : 0.f; pe[1] = k1 ? pe[1] : 0.f; sa[2 * rp] = pe[0]; sa[2 * rp + 1] = pe[1]; ls2 = ls2 + pe; }
                }
            }
            const float ls = ls2[0] + ls2[1];
            lsum[qb] += ls;
#pragma unroll
            for (int s2 = 0; s2 < 2; ++s2) {
                u32x4 w; w.x = cvt_pk_bf16(sa[8 * s2 + 0], sa[8 * s2 + 1]); w.y = cvt_pk_bf16(sa[8 * s2 + 2], sa[8 * s2 + 3]); w.z = cvt_pk_bf16(sa[8 * s2 + 4], sa[8 * s2 + 5]); w.w = cvt_pk_bf16(sa[8 * s2 + 6], sa[8 * s2 + 7]);
                const bf16x8 pa = __builtin_bit_cast(bf16x8, w);
#pragma unroll
                for (int db = 0; db < 2; ++db) o[qb][db] = __builtin_amdgcn_mfma_f32_32x32x16_bf16(pa, vf[db][s2], o[qb][db], 0, 0, 0);
            }
        }
    }
    if (PF && next_pool >= 0) pool_fetch(pr, U, Wgt, next_pool, tid);
#pragma unroll
    for (int qb = 0; qb < 2; ++qb) { const float lt = lsum[qb] + __shfl_xor(lsum[qb], 32) + __builtin_amdgcn_exp2f((sink - mx[qb]) * L2E); if (hh == 0) lsc[qb * 32 + l31] = 1.0f / lt; }
    asm volatile("s_waitcnt lgkmcnt(0)" ::: "memory");
#pragma unroll
    for (int qb = 0; qb < 2; ++qb)
#pragma unroll
        for (int r = 0; r < 16; ++r) { const int q = crow(r, hh); const float li = lsc[qb * 32 + q];
            bf16_t* op = AY + (size_t)(tok0 + 64 * qh + 32 * qb + q) * DM + h * 64 + l31;
            op[0] = f2bf(o[qb][0][r] * li); op[32] = f2bf(o[qb][1][r] * li); }
    __syncthreads();
}

__device__ __forceinline__ void pool_pair(LAS unsigned char* lds, const bf16_t* __restrict__ U, bf16_t* __restrict__ AY, int pair, int tid, PoolRegs& pr, int next_pair) {
    constexpr int NPU_ = (NTOK / 128) * 4;
    pool_put(pr, lds, tid);
    if (next_pair >= 0) pool_fetch(pr, U, nullptr, next_pair, tid);
    __syncthreads();
#pragma unroll
    for (int w = 0; w < 2; ++w) { const int unit = w ? NPU_ - 1 - pair : pair;
        const int g = unit & 3, tt = unit >> 2, tok0 = tt * 128, t0 = tok0 % SEQ;
        LAS unsigned char* Ps = lds + w * PL_YS_OFF;
        const int hw = 1 << g;
        const int c8 = tid & 15, tl0 = (tid >> 4) * 4;
        f32x4 s0 = (f32x4){0.f, 0.f, 0.f, 0.f}, s1 = s0;
        for (int q = 0; q < 2 * hw; ++q) { f32x4 a0, a1; pg8::unpack8(*(const LAS u32x4*)(Ps + (tl0 + 8 - hw + q) * PL_STRIDE + c8 * 16), a0, a1); s0 = s0 + a0; s1 = s1 + a1; }
#pragma unroll
        for (int i = 0; i < 4; ++i) {
            const int tl = tl0 + i, t = t0 + tl, lo = max(t - hw, 0), hi = min(t + hw - 1, SEQ - 1);
            const float inv = 1.0f / (float)(hi - lo + 1);
            f32x4 p0, p1; pg8::unpack8(*(const LAS u32x4*)(Ps + (tl + 8) * PL_STRIDE + c8 * 16), p0, p1);
            *(u32x4*)(AY + (size_t)(tok0 + tl) * DM + 512 + 128 * g + 8 * c8) = pg8::pack8(s0 * inv - p0, s1 * inv - p1);
            if (i < 3) { f32x4 a0, a1, b0, b1; pg8::unpack8(*(const LAS u32x4*)(Ps + (tl + 8 + hw) * PL_STRIDE + c8 * 16), a0, a1); pg8::unpack8(*(const LAS u32x4*)(Ps + (tl + 8 - hw) * PL_STRIDE + c8 * 16), b0, b1);
                s0 = s0 + (a0 - b0); s1 = s1 + (a1 - b1); }
        }
    }
    __syncthreads();
}

struct MArgs { const float* in[18]; float* out; unsigned char* ws; int ph_lo, ph_hi, li, pad; };

__global__ void __launch_bounds__(NWAVES * 64, 2) mega(MArgs a) {
    extern __shared__ __attribute__((aligned(16))) unsigned char lds_raw[];
    LAS unsigned char* lds = (LAS unsigned char*)lds_raw;
    volatile LAS unsigned* XW = (volatile LAS unsigned*)(lds + LDSX_OFF);
    const int wave = __builtin_amdgcn_readfirstlane((int)threadIdx.x >> 6);
#define PHASE_IDS const int lane = lane_id_here(); const int tid = wave * 64 + lane; (void)tid;
    const int G = gridDim.x, bx = blockIdx.x;
    const int vcu = (G % 8 == 0) ? (bx % 8) * (G / 8) + bx / 8 : bx;
#define ws (a.ws)
#define ctl ((unsigned*)(ws + WS_CTL))
#define U ((bf16_t*)(ws + WS_U))
#define AY ((bf16_t*)(ws + WS_AY))
#define MIX ((bf16_t*)(ws + WS_MIX))
#define XB ((bf16_t*)(ws + WS_XB))
#define Z ((bf16_t*)(ws + WS_Z))
#define YB ((bf16_t*)(ws + WS_XS))
#define Wint ((bf16_t*)(ws + WS_WIN))
#define Wab ((bf16_t*)(ws + WS_WAB))
#define Wot ((bf16_t*)(ws + WS_WO))
#define W1t ((bf16_t*)(ws + WS_W1))
#define W2t ((bf16_t*)(ws + WS_W2))
#define Wgt ((bf16_t*)(ws + WS_WG))
#define X8 ((unsigned char*)(ws + WS_X8))
#define Wint8 ((unsigned char*)(ws + WS_WIN8))
#define WgT ((float*)(ws + WS_WR))
#define H8 ((unsigned char*)(ws + WS_H1B))
#define slotmap ((int*)(ws + WS_RT))
#define ACT8 ((unsigned char*)(ws + WS_ACT))
#define STAT ((float*)(ws + WS_STAT))
#define te ((int*)(ws + WS_TE))
#define tg ((float*)(ws + WS_TG))
#define tr ((int*)(ws + WS_TR))
    { PHASE_IDS; if (tid < 64) XW[tid] = 0u; }
    __syncthreads();
    XcdBarrier bar = xcd_barrier_post(ctl + CW_BAR + a.li * XCD_BAR_WORDS, XW, wave);
    const int lo = a.ph_lo, hi = a.ph_hi;
    if ((PROBE_T >= 0 || PROBE_SKEW) && bx == 0 && threadIdx.x == 0) { const unsigned long long t_ = __builtin_amdgcn_s_memrealtime(); XW[8] = (unsigned)t_; XW[9] = (unsigned)(t_ >> 32); }
#define IN(k) (lo <= (k) && (k) < hi)
#ifndef PROBE_N
#define PROBE_N 2
#endif
#define NREP(k) ((k) == PROBE_PH ? PROBE_N : 1)
#define MARK(m) do { if (PROBE_T == (m) && bx == 0 && threadIdx.x == 0) { const unsigned long long t_ = __builtin_amdgcn_s_memrealtime(); XW[10] = (unsigned)t_; XW[11] = (unsigned)(t_ >> 32); } } while (0)
#ifndef PROBE_BARX
#define PROBE_BARX 0
#endif
#ifndef PROBE_BARF
#define PROBE_BARF 0
#endif
#define SEAM(k) do { MARK(2 * (k)); if (PROBE_SKEW && xb_leader(wave)) ctl[32768 + (k) * 256 + blockIdx.x] = (unsigned)__builtin_amdgcn_s_memrealtime(); if (IN(k) && IN((k) + 1)) { xcd_barrier(bar, wave); for (int bx_ = 0; bx_ < PROBE_BARX; ++bx_) xcd_barrier<PROBE_BARF>(bar, wave); } MARK(2 * (k) + 1); } while (0)

    if (IN(0)) for (int rep_ = 0; rep_ < NREP(0); ++rep_) {
        PHASE_IDS;
        LAS float* scr = (LAS float*)(lds + wave * 16384);
        const int gw = vcu * NWAVES + wave, NGW = G * NWAVES;
        constexpr int I_IN = (DM / 64) * (INW / 32), I_AB = (512 / 64) * (DM / 32), I_O = (DM / 64) * (DM / 32);
        constexpr int I_G = (128 / 64) * (128 / 32);
        constexpr int NITEMS = I_IN + I_AB + I_O;
        for (int it = gw; it < NITEMS; it += NGW) {
            int r = it;
            if (r < I_IN) { const int nb = INW / 32, n0 = 32 * (r % nb);
                if (n0 >= OP && n0 < OGA) p0_item<false>(a.in[1], INW, 64 * (r / nb), n0, Wint, DM, n0, 0, scr, lane);
                else p0_item<false, true>(a.in[1], INW, 64 * (r / nb), n0, (bf16_t*)Wint8, DM, n0, 0, scr, lane);
                continue; } r -= I_IN;
            if (r < I_AB) { const int nb = DM / 32; p0_item<false>(a.in[3], DM, 64 * (r / nb), 32 * (r % nb), Wab, DM, 32 * (r % nb), 0, scr, lane); continue; } r -= I_AB;
            { const int nb = DM / 32; p0_item<false, true>(a.in[7], DM, 64 * (r / nb), 32 * (r % nb), Wot, DM, 32 * (r % nb), 0, scr, lane); }
        }
        {
            const float* wg = a.in[4]; const float* psc = a.in[5]; const float* wpb = a.in[6];
            for (int task = (gw + NGW / 2) % NGW; task < 1024; task += NGW) {
                const int g = task >> 8, c0 = 8 * ((task >> 4) & 15), n = 64 * (task & 15) + lane;
                float fa[8];
#pragma unroll
                for (int i = 0; i < 8; ++i) fa[i] = 0.f;
#pragma unroll 8
                for (int d = 0; d < 128; ++d) { const float bcol = psc[g * 128 + d] * wpb[(size_t)(g * 128 + d) * DM + n];
#pragma unroll
                    for (int i = 0; i < 8; ++i) fa[i] = fmaf(wg[(size_t)(g * 128 + c0 + i) * 128 + d], bcol, fa[i]); }
                u32x4 o; o.x = cvt_pk_bf16(fa[0], fa[1]); o.y = cvt_pk_bf16(fa[2], fa[3]); o.z = cvt_pk_bf16(fa[4], fa[5]); o.w = cvt_pk_bf16(fa[6], fa[7]);
                *(u32x4*)(Wab + (size_t)n * DM + 512 + g * 128 + c0) = o;
            }
        }
        {
            const float* g1 = a.in[8]; const float* b1 = a.in[9]; const float* wr = a.in[10]; const float* br = a.in[11];
            for (int i = gw * 64 + lane; i < NE * DM; i += NGW * 64) { const int c = i >> 5, e = i & 31;
                const float w = g1[c] * wr[c * NE + e]; const bf16_t hi = f2bf(w), lo = f2bf(w - bf2f(hi));
                ((bf16_t*)WgT)[(c >> 3) * 256 + e * 8 + (c & 7)] = hi; ((bf16_t*)WgT)[NE * DM + (c >> 3) * 256 + e * 8 + (c & 7)] = lo; }
            if (gw < 64) { const int e = gw & 31, which = gw >> 5; float sacc = 0.f;
#pragma unroll
                for (int c0 = 0; c0 < DM; c0 += 64) { const int c = c0 + lane; sacc += (which ? b1[c] : g1[c]) * wr[c * NE + e]; }
                sacc = wave_sum(sacc);
                if (lane == 0) { if (which) WgT[NE * DM + 32 + e] = sacc + br[e]; else WgT[NE * DM + e] = sacc; } }
        }
        const float* x = a.in[0];
        {
            constexpr int NCH = NTOK * DM / 1024, HW = NITEMS - 2048;
            const bool heavy = gw < HW && NGW == 2048;
            const int c0 = NGW != 2048 ? gw * ((NCH + NGW - 1) / NGW) : heavy ? gw * 6 : HW * 6 + (gw - HW) * 9, nc = NGW != 2048 ? (NCH + NGW - 1) / NGW : heavy ? 6 : 9;
            for (int cb = c0; cb < c0 + nc; cb += 3) {
                f32x4 v[3][2][2];
#pragma unroll
                for (int u = 0; u < 3; ++u)
#pragma unroll
                    for (int hq = 0; hq < 2; ++hq) { const size_t i = (size_t)(cb + u) * 1024 + 512 * hq + 8 * lane;
                        if (cb + u < NCH && cb + u < c0 + nc) { v[u][hq][0] = *(const f32x4*)(x + i); v[u][hq][1] = *(const f32x4*)(x + i + 4); } }
#pragma unroll
                for (int u = 0; u < 3; ++u)
#pragma unroll
                    for (int hq = 0; hq < 2; ++hq) { const size_t i = (size_t)(cb + u) * 1024 + 512 * hq + 8 * lane;
                        if (cb + u < NCH && cb + u < c0 + nc) { *(u32x4*)(XB + i) = pg8::pack8(v[u][hq][0], v[u][hq][1]);
                            u32x2 w8; w8.x = pk4_fp8(v[u][hq][0][0], v[u][hq][0][1], v[u][hq][0][2], v[u][hq][0][3]); w8.y = pk4_fp8(v[u][hq][1][0], v[u][hq][1][1], v[u][hq][1][2], v[u][hq][1][3]); *(u32x2*)(X8 + i) = w8; } }
            }
        }
    }
    SEAM(0);
    if (IN(1)) for (int rep_ = 0; rep_ < NREP(1); ++rep_) {
        { pg8::Gemm g{XB, Wint, DM, DM, DM, 0}; pg8::P1OrderA S{bx}; pg8::gemm_phase<pg8::EpiU, pg8::P1OrderA, true>(lds, g, S, pg8::EpiU{U, 1.0f}, wave); }
        asm volatile("s_waitcnt vmcnt(0)" ::: "memory"); __syncthreads();
        { pg8::Gemm g{(const bf16_t*)X8, (const bf16_t*)Wint8, DM / 2, DM / 2, DM / 2, 0}; pg8::P1OrderB S{bx}; pg8::gemm_phase<pg8::EpiU, pg8::P1OrderB, true, true>(lds, g, S, pg8::EpiU{U, WSC_INV}, wave); }
    }
    SEAM(1);
    if (IN(2)) for (int rep_ = 0; rep_ < NREP(2); ++rep_) {
        PHASE_IDS;
        constexpr int NPU = (NTOK / 128) * 4;
        constexpr int NAU = 2 * (SEQ / 128) * 2;
        int unit = vcu;
        { PoolRegs dummy; for (; unit + G < NAU; unit += G) attn_unit<false>(lds, U, a.in[2], AY, unit, tid, wave, lane, dummy, Wgt, -1); }
        PoolRegs pr;
        if (unit < NAU) attn_unit<true>(lds, U, a.in[2], AY, unit, tid, wave, lane, pr, Wgt, vcu < NPU / 2 ? vcu : -1);
        else if (vcu < NPU / 2) pool_fetch(pr, U, Wgt, vcu, tid);
        for (int i = vcu; i < NPU / 2; i += G) pool_pair(lds, U, AY, i, tid, pr, i + G < NPU / 2 ? i + G : -1);
    }
    SEAM(2);
    if (IN(3)) for (int rep_ = 0; rep_ < NREP(3); ++rep_) {
        PHASE_IDS;
        pg8::Gemm g{AY, Wab, DM, DM, DM, 0}; pg8::StaticOrder S; S.init(NTOK, DM, G, bx, 8);
        pg8::gemm_phase<pg8::EpiMix, pg8::StaticOrder, true>(lds, g, S, pg8::EpiMix{U, MIX}, wave);
    }
    SEAM(3);
    if (IN(4)) for (int rep_ = 0; rep_ < NREP(4); ++rep_) {
        PHASE_IDS;
        pg8::Gemm g{MIX, Wot, DM / 2, DM / 2, DM / 2, 0}; pg8::StaticOrder S; S.init(NTOK, DM, G, bx, 8);
        pg8::gemm_phase<pg8::EpiZ, pg8::StaticOrder, true, true>(lds, g, S, pg8::EpiZ{XB, Z, WSC_INV / MSC}, wave);
    }
    SEAM(4);
    if (IN(5)) {
        PHASE_IDS;
        const float* g1 = a.in[8]; const float* b1 = a.in[9];
        LAS float* part = (LAS float*)lds;
        LAS float* stat = (LAS float*)(lds + 40960);
        LAS int* lcnt = (LAS int*)(lds + 41984);
        LAS int* asg_e = (LAS int*)(lds + 43008);
        LAS int* asg_r = asg_e + 256; LAS float* asg_g = (LAS float*)(asg_e + 512);
        for (int tile = bx; tile < NTOK / 64; tile += G) {
            if (tid < 64) lcnt[tid] = 0;
            {
                f32x4 v[8][4];
#pragma unroll
                for (int i = 0; i < 8; ++i)
#pragma unroll
                    for (int hq = 0; hq < 2; ++hq) pg8::unpack8(*(const u32x4*)(Z + (size_t)(tile * 64 + 8 * wave + i) * DM + 16 * lane + 8 * hq), v[i][2 * hq], v[i][2 * hq + 1]);
                f32x4 gv[4], bv[4];
#pragma unroll
                for (int j = 0; j < 4; ++j) { gv[j] = *(const f32x4*)(g1 + 16 * lane + 4 * j); bv[j] = *(const f32x4*)(b1 + 16 * lane + 4 * j); }
#pragma unroll
                for (int i = 0; i < 8; ++i) {
                    const int r = 8 * wave + i, tok = tile * 64 + r; float sacc = 0.f;
#pragma unroll
                    for (int j = 0; j < 4; ++j) sacc += (v[i][j][0] + v[i][j][1]) + (v[i][j][2] + v[i][j][3]);
                    const float mean = wave_sum(sacc) * (1.0f / DM); float q = 0.f;
#pragma unroll
                    for (int j = 0; j < 4; ++j) { v[i][j] = v[i][j] - mean; q += (v[i][j][0] * v[i][j][0] + v[i][j][1] * v[i][j][1]) + (v[i][j][2] * v[i][j][2] + v[i][j][3] * v[i][j][3]); }
                    const float rstd = rsqrtf(wave_sum(q) * (1.0f / DM) + LN_EPS);
                    u32x4 o8;
#pragma unroll
                    for (int j = 0; j < 4; ++j) { const f32x4 hv = v[i][j] * rstd * gv[j] + bv[j]; o8[j] = pk4_fp8(hv[0], hv[1], hv[2], hv[3]); }
                    *(u32x4*)(H8 + (size_t)tok * DM + 16 * lane) = o8;
                    if (lane == 0) { stat[2 * r] = mean; stat[2 * r + 1] = rstd; STAT[2 * tok] = mean; STAT[2 * tok + 1] = rstd; }
                }
            }
            {
                const int tt = wave >> 2, kq = wave & 3, half = lane >> 5, j32 = lane & 31;
                const bf16_t* zr = Z + (size_t)(tile * 64 + 32 * tt + j32) * DM + 256 * kq + 8 * half;
                const bf16_t* wrow = (const bf16_t*)WgT + (size_t)((32 * kq + half) * 32 + j32) * 8;
                f32x16 acc;
#pragma unroll
                for (int r = 0; r < 16; ++r) acc[r] = 0.f;
#pragma unroll 8
                for (int g = 0; g < 16; ++g) { const bf16x8 az = *(const bf16x8*)(zr + 16 * g), bh = *(const bf16x8*)(wrow + 512 * g), bl = *(const bf16x8*)(wrow + NE * DM + 512 * g);
                    acc = __builtin_amdgcn_mfma_f32_32x32x16_bf16(az, bl, acc, 0, 0, 0); acc = __builtin_amdgcn_mfma_f32_32x32x16_bf16(az, bh, acc, 0, 0, 0); }
#pragma unroll
                for (int r = 0; r < 16; ++r) part[((tt * 4 + kq) * 32 + ((r & 3) + 8 * (r >> 2) + 4 * half)) * 33 + j32] = acc[r];
            }
            __syncthreads();
            {
                const int e = lane & 31, hf = lane >> 5;
                const float Ge = WgT[NE * DM + e], Bce = WgT[NE * DM + 32 + e];
#pragma unroll
                for (int i = 0; i < 4; ++i) {
                    const int t = 8 * wave + 2 * i + hf; const float mean = stat[2 * t], rstd = stat[2 * t + 1];
                    const LAS float* pp = part + ((t >> 5) * 4 * 32 + (t & 31)) * 33 + e;
                    float lg = rstd * (((pp[0] + pp[32 * 33]) + (pp[2 * 32 * 33] + pp[3 * 32 * 33])) - mean * Ge) + Bce;
                    unsigned uo = __float_as_uint(lg); uo = (uo & 0x80000000u) ? ~uo : (uo | 0x80000000u);
                    unsigned key = (uo & ~31u) | (unsigned)(31 - e);
                    float sv[4]; int se[4];
#pragma unroll
                    for (int k = 0; k < 4; ++k) { const unsigned mk = max32u(key); if (key == mk) key = 0u;
                        se[k] = 31 - (int)(mk & 31u); const unsigned um = mk & ~31u; sv[k] = __uint_as_float((um & 0x80000000u) ? (um & 0x7fffffffu) : ~um); }
                    const float e1 = __expf(sv[1] - sv[0]), e2 = __expf(sv[2] - sv[0]), e3 = __expf(sv[3] - sv[0]), rs = 1.0f / (1.0f + e1 + e2 + e3);
                    if (e < 4) { const int myE = e == 0 ? se[0] : e == 1 ? se[1] : e == 2 ? se[2] : se[3]; const float myG = (e == 0 ? 1.0f : e == 1 ? e1 : e == 2 ? e2 : e3) * rs;
                        const int slot = t * 4 + e; asg_e[slot] = myE; asg_g[slot] = myG; asg_r[slot] = __hip_atomic_fetch_add(&lcnt[myE], 1, __ATOMIC_RELAXED, __HIP_MEMORY_SCOPE_WORKGROUP); }
                }
            }
            __syncthreads();
            if (tid < 32) lcnt[32 + tid] = (int)__hip_atomic_fetch_add(&ctl[tid], (unsigned)lcnt[tid], __ATOMIC_RELAXED, __HIP_MEMORY_SCOPE_AGENT);
            __syncthreads();
            if (tid < 256) { const int as = tile * 256 + tid, ee = asg_e[tid], rk = lcnt[32 + ee] + asg_r[tid]; te[as] = ee; tg[as] = asg_g[tid]; tr[as] = rk; slotmap[ee * NTOK + rk] = as >> 2; }
            __syncthreads();
        }
        {
            const int gw = vcu * NWAVES + wave, NGW = G * NWAVES;
            if (G == 256) conv_w1_dyn(a.in[12], W1t, (LAS float*)(lds + wave * 16384), ctl + 1024 + 64 * (bx & 7), gw, NGW, 6, 6 * NGW + (bx & 7) * (2 * NGW / 8), 2 * NGW / 8, lane);
            else conv_w1(a.in[12], W1t, (LAS float*)(lds + wave * 16384), 0, CONV_I1, gw, NGW, lane);
        }
    }
    SEAM(5);
    if (IN(7) || IN(8)) {
        LAS int* tile_e = (LAS int*)(lds + LDSX_OFF + 256);
        LAS int* tfirst = (LAS int*)(lds + LDSX_OFF + 2048);
        if (wave == 0) {
            const int ln_ = lane_id_here(), e = ln_ & 31; const int nt = ln_ < 32 ? (((int)ctl[e] + 255) >> 8) : 0;
            int incl = nt;
#pragma unroll
            for (int o = 1; o < 32; o <<= 1) { const int v = __shfl_up(incl, o); if (ln_ >= o) incl += v; }
            const int ps = incl - nt;
            if (ln_ < 32) { tfirst[e] = ps; tfirst[32 + e] = (int)ctl[e]; for (int i = 0; i < nt; ++i) tile_e[1 + ps + i] = e; }
            if (ln_ == 31) tile_e[0] = incl;
        }
        __syncthreads();
        const int nT = tile_e[0];
        if (IN(7)) for (int rep_ = 0; rep_ < NREP(7); ++rep_) {
            pg8::Gemm g{(const bf16_t*)H8, W1t, DM / 2, DM / 2, DM / 2, (size_t)2 * DE * DM}; pg8::MoeOrder S{nT, DE / 128, nT * (DE / 128), G, bx, tile_e + 1};
            LAS unsigned short* rowlds = (LAS unsigned short*)(lds + LDSX_OFF + 4096);
            LAS bf16_t* bl1 = (LAS bf16_t*)(lds + LDSX_OFF + 4096 + 5120);
            {
                PHASE_IDS; const float* b1g = a.in[13];
                int rowv[10]; float bsv[10];
#pragma unroll
                for (int i = 0; i < 10; ++i) { pg8::Unit u; rowv[i] = 0; bsv[i] = 0.f;
                    if (S.next(i, u) && tid < 256) { const int rr = (u.pm - tfirst[u.e]) * 256 + tid;
                        if (rr < tfirst[32 + u.e]) rowv[i] = slotmap[u.e * NTOK + rr];
                        bsv[i] = b1g[(size_t)u.e * 2 * DE + (tid >> 7) * DE + u.pn * 128 + (tid & 127)]; } }
#pragma unroll
                for (int i = 0; i < 10; ++i) if (tid < 256) { rowlds[i * 256 + tid] = (unsigned short)rowv[i]; bl1[i * 256 + tid] = f2bf(bsv[i]); }
            }
            __syncthreads();
            const int nU = nT * (DE / 128), rounds = (nU + G - 1) / G, nlong = nU - (rounds - 1) * G, nshort = G - nlong;
            constexpr int NP2 = CONV_I2 / 2;
            const int q_long = max(NP2 - 32 * nshort, 0) / G, rem = max(NP2 - (q_long * G + 32 * nshort), 0);
            const int pfirst = bx < nlong ? bx * q_long + min(bx, rem) : nlong * q_long + (bx - nlong) * (q_long + 32) + min(bx, rem);
            const int plast = min(pfirst + (bx < nlong ? q_long : q_long + 32) + (bx < rem ? 1 : 0), NP2);
            const bool front = bx >= nlong && ((bx >> 3) & 1);
            if (front) { conv_w2(a.in[14], W2t, (LAS float*)(lds + wave * 16384), 2 * pfirst, 2 * plast, wave, NWAVES, lane_id_here()); __syncthreads(); }
            pg8::gemm_phase<pg8::EpiAct, pg8::MoeOrder, true, true, true>(lds, g, S, pg8::EpiAct{bl1, ACT8}, wave, rowlds);
            asm volatile("s_waitcnt vmcnt(0)" ::: "memory"); __syncthreads();
            if (!front) conv_w2(a.in[14], W2t, (LAS float*)(lds + wave * 16384), 2 * pfirst, 2 * plast, wave, NWAVES, lane_id_here());
            if (bx == G - 1 && plast < NP2) conv_w2(a.in[14], W2t, (LAS float*)(lds + wave * 16384), 2 * plast, CONV_I2, wave, NWAVES, lane_id_here());
        }
        SEAM(7);
        if (IN(8)) for (int rep_ = 0; rep_ < NREP(8); ++rep_) {
            pg8::Gemm g{(const bf16_t*)ACT8, W2t, DE / 2, DE / 2, DE / 2, (size_t)DM * DE}; pg8::MoeOrder S{nT, DM / 256, nT * (DM / 256), G, bx, tile_e + 1};
            LAS float* bl2 = (LAS float*)(lds + LDSX_OFF + 4096);
            { PHASE_IDS; const float* b2g = a.in[15]; float bsv[6];
#pragma unroll
              for (int i = 0; i < 6; ++i) { pg8::Unit u; bsv[i] = 0.f; if (S.next(i, u) && tid < 256) bsv[i] = b2g[(size_t)u.e * DM + u.pn * 256 + tid]; }
#pragma unroll
              for (int i = 0; i < 6; ++i) if (tid < 256) bl2[i * 256 + tid] = bsv[i]; }
            __syncthreads();
            pg8::gemm_phase<pg8::EpiY, pg8::MoeOrder, true, true>(lds, g, S, pg8::EpiY{bl2, YB}, wave);
        }
    }
    SEAM(8);
    if (IN(9)) for (int rep_ = 0; rep_ < NREP(9); ++rep_) {
        PHASE_IDS;
        const float* g1 = a.in[8]; const float* b1 = a.in[9]; const float* g2 = a.in[16]; const float* b2 = a.in[17];
        const int gw = vcu * NWAVES + wave, NGW = G * NWAVES;
        LAS int* pst = (LAS int*)(lds + LDSX_OFF + 2048);
        if (wave == 0) {
            const int e = lane & 31; const int nr = lane < 32 ? ((((int)ctl[e] + 255) >> 8) << 8) : 0;
            int incl = nr;
#pragma unroll
            for (int o = 1; o < 32; o <<= 1) { const int v = __shfl_up(incl, o); if (lane >= o) incl += v; }
            if (lane < 32) pst[e] = incl - nr;
        }
        __syncthreads();
        f32x4 g1v[4], b1v[4], g2v[4], b2v[4];
#pragma unroll
        for (int j = 0; j < 4; ++j) { const int c = 512 * (j >> 1) + 8 * lane + 4 * (j & 1); g1v[j] = *(const f32x4*)(g1 + c); b1v[j] = *(const f32x4*)(b1 + c); g2v[j] = *(const f32x4*)(g2 + c); b2v[j] = *(const f32x4*)(b2 + c); }
        typedef int i32x4_t __attribute__((ext_vector_type(4)));
        f32x2 nst = *(const f32x2*)(STAT + 2 * gw); i32x4_t nte = *(const i32x4_t*)(te + gw * 4), ntr = *(const i32x4_t*)(tr + gw * 4); f32x4 nwk = *(const f32x4*)(tg + gw * 4);
        for (int tok = gw; tok < NTOK; tok += NGW) {
            const float mean1 = nst[0], rstd1 = nst[1];
            int dk[4]; float wk[4];
#pragma unroll
            for (int k = 0; k < 4; ++k) { dk[k] = pst[nte[k]] + ntr[k]; wk[k] = nwk[k]; }
            { const int nt_ = tok + NGW < NTOK ? tok + NGW : tok;
              nst = *(const f32x2*)(STAT + 2 * nt_); nte = *(const i32x4_t*)(te + nt_ * 4); ntr = *(const i32x4_t*)(tr + nt_ * 4); nwk = *(const f32x4*)(tg + nt_ * 4); }
            f32x4 v[4]; float sacc = 0.f;
#pragma unroll
            for (int ch = 0; ch < 2; ++ch) { const int c = 512 * ch + 8 * lane;
                f32x4 z0, z1; pg8::unpack8(*(const u32x4*)(Z + (size_t)tok * DM + c), z0, z1);
                f32x4 f0 = (f32x4){0.f, 0.f, 0.f, 0.f}, f1 = f0;
#pragma unroll
                for (int k = 0; k < 4; ++k) { f32x4 y0, y1; pg8::unpack8(*(const u32x4*)(YB + (size_t)dk[k] * DM + c), y0, y1); f0 = f0 + wk[k] * y0; f1 = f1 + wk[k] * y1; }
                v[2 * ch] = ALPHA * ((z0 - mean1) * rstd1 * g1v[2 * ch] + b1v[2 * ch]) + f0; v[2 * ch + 1] = ALPHA * ((z1 - mean1) * rstd1 * g1v[2 * ch + 1] + b1v[2 * ch + 1]) + f1;
                sacc += ((v[2 * ch][0] + v[2 * ch][1]) + (v[2 * ch][2] + v[2 * ch][3])) + ((v[2 * ch + 1][0] + v[2 * ch + 1][1]) + (v[2 * ch + 1][2] + v[2 * ch + 1][3])); }
            const float mean = wave_sum(sacc) * (1.0f / DM); float q = 0.f;
#pragma unroll
            for (int j = 0; j < 4; ++j) { v[j] = v[j] - mean; q += (v[j][0] * v[j][0] + v[j][1] * v[j][1]) + (v[j][2] * v[j][2] + v[j][3] * v[j][3]); }
            const float rstd = rsqrtf(wave_sum(q) * (1.0f / DM) + LN_EPS);
#pragma unroll
            for (int j = 0; j < 4; ++j) { const int c = 512 * (j >> 1) + 8 * lane + 4 * (j & 1); __builtin_nontemporal_store(v[j] * rstd * g2v[j] + b2v[j], (f32x4*)(a.out + (size_t)tok * DM + c)); }
        }
    }
    if (PROBE_SKEW) {
        if (xb_leader(wave)) ctl[32768 + 9 * 256 + blockIdx.x] = (unsigned)__builtin_amdgcn_s_memrealtime();
        xcd_barrier(bar, wave);
        if (bx == 0) {
            const unsigned t0 = XW[8];
            for (int k = 0; k < 10; ++k) if ((PROBE_SKEW >> k) & 1) { if ((int)threadIdx.x < G) { const unsigned d = ctl[32768 + k * 256 + threadIdx.x] - t0;
                __hip_atomic_fetch_max((LAS unsigned*)&XW[16 + k], d, __ATOMIC_RELAXED, __HIP_MEMORY_SCOPE_WORKGROUP); __hip_atomic_fetch_add((LAS unsigned*)&XW[32 + k], d, __ATOMIC_RELAXED, __HIP_MEMORY_SCOPE_WORKGROUP); } }
            __syncthreads();
#ifdef PROBE_CLS_K
            if ((int)threadIdx.x >= PROBE_CLS_LO && (int)threadIdx.x < PROBE_CLS_HI) __hip_atomic_fetch_add((LAS unsigned*)&XW[48], ctl[32768 + PROBE_CLS_K * 256 + threadIdx.x] - t0, __ATOMIC_RELAXED, __HIP_MEMORY_SCOPE_WORKGROUP);
            __syncthreads();
#endif
            if (threadIdx.x == 0) { unsigned tot = 0; for (int k = 0; k < 10; ++k) if ((PROBE_SKEW >> k) & 1) tot += XW[16 + k] - XW[32 + k] / (unsigned)G;
#ifdef PROBE_CLS_K
                tot = XW[48] / (unsigned)(PROBE_CLS_HI - PROBE_CLS_LO);
#endif
                const unsigned long long t1 = __builtin_amdgcn_s_memrealtime(); while (__builtin_amdgcn_s_memrealtime() - t1 < (unsigned long long)tot) __builtin_amdgcn_s_sleep(8); }
        }
    }
    if (PROBE_T >= 0 && bx == 0 && threadIdx.x == 0) { const unsigned long long tstart = XW[8] | ((unsigned long long)XW[9] << 32), tmark = XW[10] | ((unsigned long long)XW[11] << 32); const unsigned long long dt = tmark - tstart, t1 = __builtin_amdgcn_s_memrealtime(); while (__builtin_amdgcn_s_memrealtime() - t1 < dt) __builtin_amdgcn_s_sleep(8); }
#undef IN
#undef SEAM
#undef ws
#undef ctl
#undef U
#undef AY
#undef MIX
#undef XB
#undef Z
#undef YB
#undef Wint
#undef Wab
#undef Wot
#undef W1t
#undef W2t
#undef Wgt
#undef X8
#undef Wint8
#undef WgT
#undef H8
#undef slotmap
#undef ACT8
#undef STAT
#undef te
#undef tg
#undef tr
}

extern "C" void kernel_launch(void* const* d_in, const int* in_sizes, int n_in, void* d_out, int out_size, void* d_ws, size_t ws_size, hipStream_t stream) {
    static int grid = 0;
    if (grid == 0) {
        if (n_in != 18 || ws_size < WS_END) { fprintf(stderr, "kernel_launch: unexpected n_in %d / ws_size %zu (need %zu)\n", n_in, ws_size, (size_t)WS_END); grid = -1; return; }
        int dev = 0, cus = 0;
        if (hipGetDevice(&dev) != hipSuccess || hipDeviceGetAttribute(&cus, hipDeviceAttributeMultiprocessorCount, dev) != hipSuccess) { grid = -1; return; }
        if (hipFuncSetAttribute((const void*)mega, hipFuncAttributeMaxDynamicSharedMemorySize, LDS_BYTES) != hipSuccess) { fprintf(stderr, "kernel_launch: hipFuncSetAttribute failed\n"); grid = -1; return; }
        grid = cus;
    }
    if (grid < 0) return;
    const float* x = (const float*)d_in[0]; const float* sinks = (const float*)d_in[2];
    const float* w_pg = (const float*)d_in[4]; const float* pscale = (const float*)d_in[5];
    const float* ln1g = (const float*)d_in[8]; const float* ln1b = (const float*)d_in[9]; const float* w_r = (const float*)d_in[10]; const float* b_r = (const float*)d_in[11];
    const float* ln2g = (const float*)d_in[16]; const float* ln2b = (const float*)d_in[17];
    char* ws = (char*)d_ws; float* out = (float*)d_out;
    int* ctl = (int*)(ws + WS_CTL); bf16_t* U = (bf16_t*)(ws + WS_U); bf16_t* AY = (bf16_t*)(ws + WS_AY);
    bf16_t* H1B = (bf16_t*)(ws + WS_H1B); float* Z = (float*)(ws + WS_Z); float* STAT = (float*)(ws + WS_STAT);
    int* te = (int*)(ws + WS_TE); float* tg = (float*)(ws + WS_TG); int* tr = (int*)(ws + WS_TR); int* td = (int*)(ws + WS_TD);
    bf16_t* XS = (bf16_t*)(ws + WS_XS); bf16_t* YB = XS;
    (void)x; (void)in_sizes; (void)out_size;

    if (hipMemsetAsync(ctl, 0, (size_t)(CW_BAR + 5 * XCD_BAR_WORDS) * 4, stream) != hipSuccess) return;
    MArgs a{};
    for (int i = 0; i < 18; ++i) a.in[i] = (const float*)d_in[i];
    a.out = out; a.ws = (unsigned char*)d_ws;
    a.ph_lo = 0; a.ph_hi = 10; a.li = 0;
    hipLaunchKernelGGL(mega, dim3(grid), dim3(NWAVES * 64), LDS_BYTES, stream, a);
#if defined(PROBE_LPH)
#ifndef PROBE_SUB
#define PROBE_SUB 0
#endif
    for (int r = 0; r < PROBE_LN; ++r) { a.ph_lo = PROBE_LPH; a.ph_hi = PROBE_LPH + 1; a.li = 1 + r; a.pad = PROBE_SUB; hipLaunchKernelGGL(mega, dim3(grid), dim3(NWAVES * 64), LDS_BYTES, stream, a); }
#endif
}
```
